# Optimizing an MI355X kernel written in HIP

```python
import math
import jax
import jax.numpy as jnp
from jax import lax
import numpy as np

D_MODEL = 1024
BATCH = 32
SEQ = 256
DEPTH = 4
DEC_BATCH = 4
DEC_SEQ = 4096
PAST_LEN = 512

GRID_W = 64
MLA_H = 8
MLA_DN = 64
MLA_DR = 32
MLA_DV = 64
Q_RANK = 256
KV_RANK = 128
ML_H = 4
ML_D = 64
ML_W = 256
HG_H = 4
HG_DK = 64
HG_DV = 64
HG_W = 256
HG_KW = 256
MIX_W = 1024
FF = 2816
CHUNK = 64
Q_BLOCK = 128
ROPE_BASE = 10000.0
ALPHA = (2 * DEPTH) ** 0.25
BETA = (8 * DEPTH) ** -0.25
EPS = 1e-6
MASK_NEG = -1e30
TINY = 1e-30
IN_SIZES = (Q_RANK, KV_RANK, MLA_DR, ML_W, ML_W, ML_W, ML_W, ML_H, ML_H, ML_H, ML_H, HG_W, HG_KW, HG_KW, HG_W, HG_W)
IN_COLS = 2736

kernel_name = 'hybrid_mla_mlstm_hgrn2_diffusion_step'


def layernorm(x, g, b):
    xf = x.astype(jnp.float32)
    mu = xf.mean(-1, keepdims=True)
    var = jnp.mean(jnp.square(xf - mu), -1, keepdims=True)
    return ((xf - mu) * lax.rsqrt(var + EPS) * g.astype(jnp.float32) + b.astype(jnp.float32)).astype(x.dtype)


def rmsnorm(x, g):
    xf = x.astype(jnp.float32)
    return (xf * lax.rsqrt(jnp.mean(xf * xf, -1, keepdims=True) + EPS) * g.astype(jnp.float32)).astype(x.dtype)


def to_heads(x, n_heads):
    B, T, W = x.shape
    return x.reshape(B, T, n_heads, W // n_heads).transpose(0, 2, 1, 3)


def from_heads(x):
    B, H, T, d = x.shape
    return x.transpose(0, 2, 1, 3).reshape(B, T, H * d)


def flip(a):
    return jnp.flip(a, axis=2)


def axial_rope(n):
    n_rows = n // GRID_W
    row = jnp.repeat(jnp.arange(n_rows, dtype=jnp.float32), GRID_W)
    col = jnp.tile(jnp.arange(GRID_W, dtype=jnp.float32), n_rows)
    half = MLA_DR // 2
    freqs = ROPE_BASE ** (-jnp.arange(half // 2, dtype=jnp.float32) * (2.0 / half))
    ar = row[:, None] * freqs
    ac = col[:, None] * freqs
    ang = jnp.concatenate([ar, ar, ac, ac], -1)
    return jnp.cos(ang), jnp.sin(ang)


def apply_rope(x, cos, sin):
    x1, x2, x3, x4 = jnp.split(x, 4, axis=-1)
    rot = jnp.concatenate([-x2, x1, -x4, x3], -1)
    return (x.astype(jnp.float32) * cos + rot.astype(jnp.float32) * sin).astype(x.dtype)


def attend(q_nope, q_pe, k_nope, k_pe, v):
    B, T, H, _ = q_nope.shape
    nb = T // Q_BLOCK
    scale = (MLA_DN + MLA_DR) ** -0.5

    def blocks(a):
        return jnp.moveaxis(a.reshape((B, nb, Q_BLOCK) + a.shape[2:]), 1, 0)

    def one_block(qs):
        qn, qp = qs
        s = (jnp.einsum('bqhd,bkhd->bhqk', qn, k_nope).astype(jnp.float32)
             + jnp.einsum('bqhr,bkr->bhqk', qp, k_pe).astype(jnp.float32))
        p = jax.nn.softmax(s * scale, axis=-1).astype(v.dtype)
        return jnp.einsum('bhqk,bkhd->bqhd', p, v)

    o = lax.map(one_block, (blocks(q_nope), blocks(q_pe)))
    return jnp.moveaxis(o, 0, 1).reshape(B, T, H * MLA_DV)


def mlstm_scan(q, k, v, ig, lf, C0, n0, m0):
    B, H, T, d = q.shape
    nc = T // CHUNK

    def chunks(a):
        return jnp.moveaxis(a.reshape(a.shape[:2] + (nc, CHUNK) + a.shape[3:]), 2, 0)

    causal = jnp.tril(jnp.ones((CHUNK, CHUNK), dtype=bool))

    def step(carry, inp):
        C, n, m = carry
        qc, kc, vc, ic, fc = inp
        b = jnp.cumsum(fc, axis=-1)
        a = b + m[..., None]
        Dm = jnp.where(causal, b[..., :, None] - b[..., None, :] + ic[..., None, :], MASK_NEG)
        mt = jnp.maximum(a, Dm.max(-1))
        ws = jnp.exp(a - mt)
        qk = jnp.einsum('bhtd,bhsd->bhts', qc, kc) * jnp.exp(Dm - mt[..., None])
        num = ws[..., None] * jnp.einsum('bhtd,bhde->bhte', qc, C) + jnp.einsum('bhts,bhse->bhte', qk, vc)
        den = ws * jnp.einsum('bhtd,bhd->bht', qc, n) + qk.sum(-1)
        h = num / jnp.maximum(jnp.abs(den), jnp.exp(-mt))[..., None]
        g = b[..., -1]
        u = g[..., None] - b + ic
        m_new = jnp.maximum(g + m, u.max(-1))
        sc = jnp.exp(g + m - m_new)
        ku = kc * jnp.exp(u - m_new[..., None])[..., None]
        C_new = sc[..., None, None] * C + jnp.einsum('bhsd,bhse->bhde', ku, vc)
        n_new = sc[..., None] * n + ku.sum(2)
        return (C_new, n_new, m_new), h

    (C, n, m), hs = lax.scan(step, (C0, n0, m0), tuple(chunks(a) for a in (q, k, v, ig, lf)))
    return jnp.moveaxis(hs, 0, 2).reshape(B, H, T, d), C, n, m


def hgrn_scan(q, k, v, lg, S0):
    B, H, T, dk = q.shape
    dv = v.shape[-1]
    nc = T // CHUNK

    def chunks(a):
        return jnp.moveaxis(a.reshape(a.shape[:2] + (nc, CHUNK) + a.shape[3:]), 2, 0)

    causal = jnp.tril(jnp.ones((CHUNK, CHUNK), dtype=bool))[:, :, None]

    def step(S, inp):
        qc, kc, vc, gc = inp
        Bc = jnp.cumsum(gc, axis=2)
        inter = jnp.einsum('bhtc,bhce->bhte', qc * jnp.exp(Bc), S)
        diff = Bc[:, :, :, None, :] - Bc[:, :, None, :, :]
        decay = jnp.where(causal, jnp.exp(jnp.where(causal, diff, 0.0)), 0.0)
        A = jnp.einsum('bhtsc,bhsc->bhts', qc[:, :, :, None, :] * decay, kc)
        o = inter + jnp.einsum('bhts,bhse->bhte', A, vc)
        gL = Bc[:, :, -1:, :]
        S_new = jnp.exp(gL[:, :, 0, :])[..., None] * S + jnp.einsum('bhsc,bhse->bhce', kc * jnp.exp(gL - Bc), vc)
        return S_new, o

    S, os_ = lax.scan(step, S0, tuple(chunks(a) for a in (q, k, v, lg)))
    return jnp.moveaxis(os_, 0, 2).reshape(B, H, T, dv), S


def mla_expand(ckv_n, w_ukv):
    B, T, _ = ckv_n.shape
    kv = (ckv_n @ w_ukv).reshape(B, T, MLA_H, MLA_DN + MLA_DV)
    return kv[..., :MLA_DN], kv[..., MLA_DN:]


def mla_mixer(cq, ckv, kpe, q_norm, w_uq, kv_norm, w_ukv, cache, rope):
    B, T, _ = cq.shape
    q = (rmsnorm(cq, q_norm) @ w_uq).reshape(B, T, MLA_H, MLA_DN + MLA_DR)
    q_nope, q_pe = q[..., :MLA_DN], q[..., MLA_DN:]
    ckv_n = rmsnorm(ckv, kv_norm)
    k_nope, v = mla_expand(ckv_n, w_ukv)
    if cache is None:
        return attend(q_nope, q_pe, k_nope, kpe, v), (ckv_n, kpe)
    cos, sin = rope
    q_pe = apply_rope(q_pe, cos[:, None, :], sin[:, None, :])
    kpe = apply_rope(kpe, cos, sin)
    ckv_c, kpe_c = cache
    kn_c, v_c = mla_expand(ckv_c, w_ukv)
    out = attend(q_nope, q_pe,
                 jnp.concatenate([k_nope, kn_c], axis=1),
                 jnp.concatenate([kpe, kpe_c], axis=1),
                 jnp.concatenate([v, v_c], axis=1))
    return out, None


def mlstm_mixer(mq, mk, mv, mo, mi_f, mi_b, mf_f, mf_b, norm_g, init):
    f32 = jnp.float32
    q = to_heads(mq, ML_H).astype(f32)
    k = to_heads(mk, ML_H).astype(f32) * (ML_D ** -0.5)
    v = to_heads(mv, ML_H).astype(f32)

    def gate(a):
        return a.astype(f32).transpose(0, 2, 1)

    ig_f, ig_b = gate(mi_f), gate(mi_b)
    lf_f, lf_b = jax.nn.log_sigmoid(gate(mf_f)), jax.nn.log_sigmoid(gate(mf_b))
    (Cf0, nf0, mf0), (Cb0, nb0, mb0) = init
    hf, Cf, nf, mf = mlstm_scan(q, k, v, ig_f, lf_f, Cf0.astype(f32), nf0.astype(f32), mf0.astype(f32))
    hb, Cb, nb, mb = mlstm_scan(flip(q), flip(k), flip(v), flip(ig_b), flip(lf_b),
                                Cb0.astype(f32), nb0.astype(f32), mb0.astype(f32))
    h = hf + flip(hb)
    mu = h.mean(-1, keepdims=True)
    var = jnp.mean(jnp.square(h - mu), -1, keepdims=True)
    h = (h - mu) * lax.rsqrt(var + EPS)
    out = from_heads(h) * norm_g.astype(f32) * jax.nn.sigmoid(mo.astype(f32))
    states = (jnp.stack([Cf, Cb], 1), jnp.stack([nf, nb], 1), jnp.stack([mf, mb], 1))
    return out.astype(mq.dtype), states


def hgrn_mixer(gq, gf_f, gf_b, gi, gg, lb, norm_g, init):
    f32 = jnp.float32
    q = jax.nn.silu(to_heads(gq, HG_H).astype(f32))
    v = to_heads(gi, HG_H).astype(f32)
    lb = lb.astype(f32).reshape(1, HG_H, 1, HG_DK)

    def decay(fr):
        fr = to_heads(fr, HG_H).astype(f32)
        f = lb + (1.0 - lb) * jax.nn.sigmoid(fr)
        return (1.0 - lb) * jax.nn.sigmoid(-fr), jnp.log(jnp.maximum(f, TINY))

    kf, lgf = decay(gf_f)
    kb, lgb = decay(gf_b)
    S0f, S0b = init
    of, Sf = hgrn_scan(q, kf, v, lgf, S0f.astype(f32))
    ob, Sb = hgrn_scan(flip(q), flip(kb), flip(v), flip(lgb), S0b.astype(f32))
    o = of + flip(ob)
    o = o * lax.rsqrt(jnp.mean(o * o, -1, keepdims=True) + EPS)
    out = from_heads(o) * norm_g.astype(f32) * jax.nn.silu(gg.astype(f32))
    return out.astype(gq.dtype), jnp.stack([Sf, Sb], 1)


def trunk_layer(x, cvec, lp, lb, cache, rope):
    B, T, _ = x.shape
    mod = (jax.nn.silu(cvec) @ lp['w_mod'] + lp['b_mod'])[:, None, :]
    sh1, sc1, g1, sh2, sc2, g2 = jnp.split(mod, 6, axis=-1)
    h = x * (1 + sc1) + sh1
    offsets = [int(o) for o in np.cumsum(IN_SIZES)[:-1]]
    (cq, ckv, kpe, mq, mk, mv, mo, mi_f, mi_b, mf_f, mf_b,
     gq, gf_f, gf_b, gi, gg) = jnp.split(h @ lp['w_in'] + lp['b_in'], offsets, axis=-1)
    if cache is None:
        f32 = jnp.float32
        ml0 = (jnp.zeros((B, ML_H, ML_D, ML_D), f32), jnp.zeros((B, ML_H, ML_D), f32), jnp.zeros((B, ML_H), f32))
        ml_init = (ml0, ml0)
        hg0 = jnp.zeros((B, HG_H, HG_DK, HG_DV), f32)
        hg_init = (hg0, hg0)
        mla_cache = None
    else:
        mla_cache, ml_init, hg_init = cache
    a_out, mla_st = mla_mixer(cq, ckv, kpe, lp['mla_q_norm'], lp['w_uq'], lp['mla_kv_norm'], lp['w_ukv'], mla_cache, rope)
    m_out, ml_st = mlstm_mixer(mq, mk, mv, mo, mi_f, mi_b, mf_f, mf_b, lp['mlstm_norm'], ml_init)
    g_out, hg_st = hgrn_mixer(gq, gf_f, gf_b, gi, gg, lb, lp['hgrn_norm'], hg_init)
    mix = jnp.concatenate([a_out, m_out, g_out], axis=-1) @ lp['w_out']
    x = layernorm(ALPHA * x + g1 * mix, lp['ln1_g'], lp['ln1_b'])
    h2 = x * (1 + sc2) + sh2
    gate, up = jnp.split(h2 @ lp['w_ffn_in'], 2, axis=-1)
    x = layernorm(ALPHA * x + g2 * ((jax.nn.silu(gate) * up) @ lp['w_ffn_out']), lp['ln2_g'], lp['ln2_b'])
    return x, (mla_st, ml_st, hg_st)


def setup_inputs(seed: int = 0) -> dict:
    key = jax.random.key(seed)
    ks = jax.random.split(key, 32)
    D = D_MODEL

    def nrm(k, shape, scale=1.0):
        return jax.random.normal(k, shape, jnp.float32) * scale

    b_mod = nrm(ks[11], (DEPTH, 6 * D), 0.02)
    b_mod = b_mod.at[:, 2 * D:3 * D].add(1.0).at[:, 5 * D:6 * D].add(1.0)
    off = np.cumsum((0,) + IN_SIZES)
    b_in = nrm(ks[13], (DEPTH, IN_COLS), 0.02)
    b_in = b_in.at[:, int(off[9]):int(off[11])].add(jnp.tile(jnp.linspace(3.0, 6.0, ML_H), 2))
    return {
        'x_prompt': nrm(ks[0], (BATCH, SEQ, D)),
        'x_sample': nrm(ks[1], (DEC_BATCH, DEC_SEQ, D)),
        'cache_mla_ckv': nrm(ks[2], (DEC_BATCH, DEPTH, PAST_LEN, KV_RANK)),
        'cache_mla_kpe': nrm(ks[3], (DEC_BATCH, DEPTH, PAST_LEN, MLA_DR)),
        'state_mlstm_C': nrm(ks[4], (DEC_BATCH, DEPTH, 2, ML_H, ML_D, ML_D), 0.3),
        'state_mlstm_n': nrm(ks[5], (DEC_BATCH, DEPTH, 2, ML_H, ML_D), 0.3),
        'state_mlstm_m': nrm(ks[6], (DEC_BATCH, DEPTH, 2, ML_H)),
        'state_hgrn_S': nrm(ks[7], (DEC_BATCH, DEPTH, 2, HG_H, HG_DK, HG_DV), 0.5),
        'c': nrm(ks[8], (DEC_BATCH, D)),
        'c_ctx': nrm(ks[9], (D,)),
        'w_mod': nrm(ks[10], (DEPTH, D, 6 * D), 0.5 * D ** -0.5),
        'b_mod': b_mod,
        'w_in': nrm(ks[12], (DEPTH, D, IN_COLS), D ** -0.5),
        'b_in': b_in,
        'mla_q_norm': 1.0 + nrm(ks[14], (DEPTH, Q_RANK), 0.02),
        'w_uq': nrm(ks[15], (DEPTH, Q_RANK, MLA_H * (MLA_DN + MLA_DR)), Q_RANK ** -0.5),
        'mla_kv_norm': 1.0 + nrm(ks[16], (DEPTH, KV_RANK), 0.02),
        'w_ukv': nrm(ks[17], (DEPTH, KV_RANK, MLA_H * (MLA_DN + MLA_DV)), KV_RANK ** -0.5),
        'mlstm_norm': 1.0 + nrm(ks[18], (DEPTH, ML_W), 0.02),
        'hgrn_lb_logits': 1.0 + nrm(ks[19], (DEPTH, HG_KW), 0.1),
        'hgrn_norm': 1.0 + nrm(ks[20], (DEPTH, HG_W), 0.02),
        'w_out': nrm(ks[21], (DEPTH, MIX_W, D), BETA * MIX_W ** -0.5),
        'ln1_g': 1.0 + nrm(ks[22], (DEPTH, D), 0.02),
        'ln1_b': nrm(ks[23], (DEPTH, D), 0.02),
        'w_ffn_in': nrm(ks[24], (DEPTH, D, 2 * FF), D ** -0.5),
        'w_ffn_out': nrm(ks[25], (DEPTH, FF, D), BETA * FF ** -0.5),
        'ln2_g': 1.0 + nrm(ks[26], (DEPTH, D), 0.02),
        'ln2_b': nrm(ks[27], (DEPTH, D), 0.02),
    }


def reference(x_prompt, x_sample, cache_mla_ckv, cache_mla_kpe, state_mlstm_C, state_mlstm_n, state_mlstm_m,
              state_hgrn_S, c, c_ctx, w_mod, b_mod, w_in, b_in, mla_q_norm, w_uq, mla_kv_norm, w_ukv,
              mlstm_norm, hgrn_lb_logits, hgrn_norm, w_out, ln1_g, ln1_b, w_ffn_in, w_ffn_out, ln2_g, ln2_b):
    lb_p = jax.nn.softmax(hgrn_lb_logits.astype(jnp.float32), axis=0)
    lbs = jnp.cumsum(lb_p, axis=0) - lb_p[0]
    rope = axial_rope(x_sample.shape[1])
    yp = x_prompt
    ys = x_sample
    ckv_l, kpe_l, mC_l, mn_l, mm_l, hS_l = [], [], [], [], [], []
    for l in range(DEPTH):
        lp = dict(w_mod=w_mod[l], b_mod=b_mod[l], w_in=w_in[l], b_in=b_in[l],
                  mla_q_norm=mla_q_norm[l], w_uq=w_uq[l], mla_kv_norm=mla_kv_norm[l], w_ukv=w_ukv[l],
                  mlstm_norm=mlstm_norm[l], hgrn_norm=hgrn_norm[l], w_out=w_out[l],
                  ln1_g=ln1_g[l], ln1_b=ln1_b[l], w_ffn_in=w_ffn_in[l], w_ffn_out=w_ffn_out[l],
                  ln2_g=ln2_g[l], ln2_b=ln2_b[l])
        yp, (mla_st, ml_st, hg_st) = trunk_layer(yp, c_ctx[None, :], lp, lbs[l], None, None)
        ckv_l.append(mla_st[0])
        kpe_l.append(mla_st[1])
        mC_l.append(ml_st[0])
        mn_l.append(ml_st[1])
        mm_l.append(ml_st[2])
        hS_l.append(hg_st)
        cache_l = ((cache_mla_ckv[:, l], cache_mla_kpe[:, l]),
                   ((state_mlstm_C[:, l, 0], state_mlstm_n[:, l, 0], state_mlstm_m[:, l, 0]),
                    (state_mlstm_C[:, l, 1], state_mlstm_n[:, l, 1], state_mlstm_m[:, l, 1])),
                   (state_hgrn_S[:, l, 0], state_hgrn_S[:, l, 1]))
        ys, _ = trunk_layer(ys, c, lp, lbs[l], cache_l, rope)
    new_mla_ckv = jnp.stack(ckv_l, axis=1)
    new_mla_kpe = jnp.stack(kpe_l, axis=1)
    new_mlstm_C = jnp.stack(mC_l, axis=1)
    new_mlstm_n = jnp.stack(mn_l, axis=1)
    new_mlstm_m = jnp.stack(mm_l, axis=1)
    new_hgrn_S = jnp.stack(hS_l, axis=1)
    return (yp, ys, new_mla_ckv, new_mla_kpe, new_mlstm_C, new_mlstm_n, new_mlstm_m, new_hgrn_S)
```

```cpp
#include <hip/hip_runtime.h>
#include <hip/hip_cooperative_groups.h>
#include <cstdio>
namespace cg = cooperative_groups;

#ifndef SINGLE
#define SINGLE 1
#endif

#define DI __device__ __forceinline__
typedef unsigned short bf16_t;
using bf16x8 = __attribute__((ext_vector_type(8))) short;
using bf16x4 = __attribute__((ext_vector_type(4))) short;
using f32x16 = __attribute__((ext_vector_type(16))) float;
using u32x4 = __attribute__((ext_vector_type(4))) unsigned;

constexpr int NTOK = 24576, NCTX = 8192, DM = 1024;
constexpr int PLD = 2880, IN_COLS = 2736, FFD = 2816;
constexpr int HLD = 1088;
constexpr int NTC = 384;
constexpr int NKV = NTOK + 2048;
constexpr float EPSF = 1e-6f;
constexpr float ALPHA = 1.6817928305074292f;
constexpr float QSCALE = 0.10206207261596577f * 1.4426950408889634f;
constexpr int C_CQ = 0, C_CKV = 256, C_KPE = 384, C_MQ = 416, C_MK = 672, C_MV = 928, C_MO = 1184, C_GATE = 1440,
              C_GQ = 1456, C_GFF = 1712, C_GFB = 1968, C_GI = 2224, C_GG = 2480;
constexpr size_t O_YP = 0, O_YS = 8388608, O_CKV = 25165824, O_KPE = 29360128, O_C = 30408704, O_N = 34603008,
                 O_M = 34668544, O_S = 34669568;

struct Params {
  const float *x_prompt, *x_sample, *cache_ckv, *cache_kpe, *st_C, *st_n, *st_m, *st_S, *c, *c_ctx, *w_mod, *b_mod,
      *w_in, *b_in, *q_norm, *w_uq, *kv_norm, *w_ukv, *ml_norm, *lb_logits, *hg_norm, *w_out, *ln1_g, *ln1_b, *w_ffi,
      *w_ffo, *ln2_g, *ln2_b;
  float* out;
  bf16_t *wb_in, *wb_uq, *wb_ukv, *wb_out, *wb_ffi, *wb_ffo;
  float *modv, *lbs, *rope;
  bf16_t *ckvc, *kpec;
  float* X1;
  bf16_t *hbuf, *proj;
  float* gates;
  bf16_t *Q, *Kn, *VtC, *VtL, *MU, *HU;
  float *Mg, *Mumax, *Mn, *Mm, *Hd;
  unsigned* bar;
  float2 *S1, *S2;
};

typedef __bf16 hbf2 __attribute__((ext_vector_type(2)));
typedef float f32x2 __attribute__((ext_vector_type(2)));
DI bf16_t f2bf(float x) { return __builtin_bit_cast(unsigned short, (__bf16)x); }
DI unsigned pk_bf16(float a, float b) {
  f32x2 v = {a, b};
  return __builtin_bit_cast(unsigned, __builtin_convertvector(v, hbf2));
}
DI float bf2f(bf16_t v) { return __uint_as_float(((unsigned)v) << 16); }
DI float bfs(short v) { return __uint_as_float(((unsigned)(unsigned short)v) << 16); }
DI int tidx() { int t = threadIdx.x; asm volatile("" : "+v"(t)); return t; }
DI int crow(int reg, int h) { return (reg & 3) + 8 * (reg >> 2) + 4 * h; }
DI float sigmoidf_(float x) { return __builtin_amdgcn_rcpf(1.f + __expf(-x)); }
DI float siluf_(float x) { return x * __builtin_amdgcn_rcpf(1.f + __expf(-x)); }
DI f32x16 mfma(bf16x8 a, bf16x8 b, f32x16 c) { return __builtin_amdgcn_mfma_f32_32x32x16_bf16(a, b, c, 0, 0, 0); }
DI f32x16 zero16() {
  f32x16 z = {0.f, 0.f, 0.f, 0.f, 0.f, 0.f, 0.f, 0.f, 0.f, 0.f, 0.f, 0.f, 0.f, 0.f, 0.f, 0.f};
  return z;
}
DI void wave_mma1(f32x16& acc, const bf16_t* A, int lda, const bf16_t* Bt, int ldb, int K, int lane) {
  const int r = lane & 31, h = lane >> 5;
  for (int k0 = 0; k0 < K; k0 += 16) {
    bf16x8 a = *(const bf16x8*)(A + r * lda + k0 + 8 * h);
    bf16x8 b = *(const bf16x8*)(Bt + r * ldb + k0 + 8 * h);
    acc = mfma(a, b, acc);
  }
}
DI int cvec_of(int row) { return row < NCTX ? 0 : 1 + ((row - NCTX) >> 12); }

DI bool tile_map(int bid, int nb, int k, int Mt, int Nt, int& mt, int& nt) {
  const int xcd = bid & 7, slot = bid >> 3, spx = nb >> 3;
  const int mpx = Mt >> 3;
  const int u = slot + k * spx;
  if (u >= mpx * Nt) return false;
  const int pw = 8 * Nt;
  const int pn = u / pw, rem = u - pn * pw;
  const int hgt = min(8, mpx - 8 * pn);
  nt = rem / hgt;
  mt = xcd * mpx + 8 * pn + (rem - nt * hgt);
  return true;
}

template <int MI, bool RS, bool TWO, class Epi>
DI void gemm_tile(const bf16_t* __restrict__ A, int lda, const bf16_t* __restrict__ Bt, int ldb, int K, int m0, int n0,
                  const Epi& epi, char* smem, bool rs_one) {
  constexpr int BM = 64 * MI;
  constexpr int NA = BM / 32;
  bf16_t* sA = (bf16_t*)smem;
  bf16_t* sB = sA + BM * 72;
  float* sRS = (float*)(sB + 128 * 72);
  const int tid = tidx(), lane = tid & 63, w = tid >> 6, wm = w >> 1, wn = w & 1;
  const int r = lane & 31, h = lane >> 5;
  f32x16 acc[MI][2];
#pragma unroll
  for (int i = 0; i < MI; ++i)
#pragma unroll
    for (int j = 0; j < 2; ++j) acc[i][j] = zero16();
  u32x4 ra0[NA], rb0[4], ra1[TWO ? NA : 1], rb1[TWO ? 4 : 1];
  const int lrow = tid >> 3, lkc = (tid & 7) * 8;
  const bf16_t* Ap = A + (size_t)(m0 + lrow) * lda + lkc;
  const bf16_t* Bp = Bt + (size_t)(n0 + lrow) * ldb + lkc;
  float ss = 0.f;
  auto gl = [&](u32x4* ra, u32x4* rb, int k0) {
#pragma unroll
    for (int i = 0; i < NA; ++i) ra[i] = *(const u32x4*)(Ap + (size_t)i * 32 * lda + k0);
#pragma unroll
    for (int i = 0; i < 4; ++i) rb[i] = *(const u32x4*)(Bp + (size_t)i * 32 * ldb + k0);
  };
  auto body = [&](u32x4* ra, u32x4* rb, int knext) {
    __syncthreads();
#pragma unroll
    for (int i = 0; i < NA; ++i) *(u32x4*)(sA + (lrow + i * 32) * 72 + lkc) = ra[i];
#pragma unroll
    for (int i = 0; i < 4; ++i) *(u32x4*)(sB + (lrow + i * 32) * 72 + lkc) = rb[i];
    __syncthreads();
    if (knext < K) gl(ra, rb, knext);
    if (RS) {
      constexpr int TPR = 256 / BM;
      constexpr int EPT = 64 / TPR;
      const bf16_t* rp = sA + (tid / TPR) * 72 + (tid % TPR) * EPT;
#pragma unroll
      for (int q = 0; q < EPT / 8; ++q) {
        bf16x8 v = *(const bf16x8*)(rp + q * 8);
#pragma unroll
        for (int j = 0; j < 8; ++j) {
          float f = bfs(v[j]);
          ss += f * f;
        }
      }
    }
    bf16x8 fa[2][MI], fb[2][2];
#pragma unroll
    for (int i = 0; i < MI; ++i) fa[0][i] = *(const bf16x8*)(sA + (wm * 32 * MI + i * 32 + r) * 72 + 8 * h);
#pragma unroll
    for (int j = 0; j < 2; ++j) fb[0][j] = *(const bf16x8*)(sB + (wn * 64 + j * 32 + r) * 72 + 8 * h);
#pragma unroll
    for (int s4 = 0; s4 < 4; ++s4) {
      const int cur = s4 & 1, nxt = cur ^ 1;
      if (s4 < 3) {
#pragma unroll
        for (int i = 0; i < MI; ++i)
          fa[nxt][i] = *(const bf16x8*)(sA + (wm * 32 * MI + i * 32 + r) * 72 + (s4 + 1) * 16 + 8 * h);
#pragma unroll
        for (int j = 0; j < 2; ++j)
          fb[nxt][j] = *(const bf16x8*)(sB + (wn * 64 + j * 32 + r) * 72 + (s4 + 1) * 16 + 8 * h);
      }
      __builtin_amdgcn_sched_barrier(0);
#pragma unroll
      for (int i = 0; i < MI; ++i)
#pragma unroll
        for (int j = 0; j < 2; ++j) acc[i][j] = mfma(fa[cur][i], fb[cur][j], acc[i][j]);
      __builtin_amdgcn_sched_barrier(0);
    }
  };
  if (TWO) {
    gl(ra0, rb0, 0);
    gl(ra1, rb1, 64);
    for (int k0 = 0; k0 < K; k0 += 128) {
      body(ra0, rb0, k0 + 128);
      body(ra1, rb1, k0 + 192);
    }
  } else {
    gl(ra0, rb0, 0);
    for (int k0 = 0; k0 < K; k0 += 64) body(ra0, rb0, k0 + 64);
  }
  if (RS) {
    constexpr int TPR = 256 / BM;
    if (TPR == 2) ss += __shfl_xor(ss, 1);
    if ((tid % TPR) == 0) sRS[tid / TPR] = rs_one ? 1.f : rsqrtf(ss / (float)K + EPSF);
    __syncthreads();
  }
  __syncthreads();
#pragma unroll
  for (int ih = 0; ih < MI / 2; ++ih)
    epi(reinterpret_cast<f32x16(&)[2][2]>(acc[2 * ih]), m0 + wm * 32 * MI + ih * 64, n0 + wn * 64, lane,
        sRS + wm * 32 * MI + ih * 64, (bf16_t*)smem + w * (64 * 72));
}


template <int NJ>
DI void stage_store(const f32x16 (&v)[2][2], bf16_t* st, bf16_t* dst, size_t ld, int lane) {
  const int r = lane & 31, h = lane >> 5;
#pragma unroll
  for (int i = 0; i < 2; ++i)
#pragma unroll
    for (int j = 0; j < NJ; ++j)
#pragma unroll
      for (int reg = 0; reg < 16; ++reg) st[(i * 32 + crow(reg, h)) * 72 + j * 32 + r] = f2bf(v[i][j][reg]);
  asm volatile("s_waitcnt lgkmcnt(0)" ::: "memory");
  constexpr int CPR = 4 * NJ;
#pragma unroll
  for (int q = 0; q < CPR; ++q) {
    const int c = lane + 64 * q;
    const int row = c / CPR, part = c % CPR;
    *(u32x4*)(dst + (size_t)row * ld + part * 8) = *(const u32x4*)(st + row * 72 + part * 8);
  }
  asm volatile("s_waitcnt lgkmcnt(0)" ::: "memory");
}

DI void rope_apply(float& v, const float* rope, int row, int r) {
  const int t = (row - NCTX) & 4095;
  const int pos = (r < 16) ? (t >> 6) : (t & 63);
  const float cs = rope[pos * 8 + (r & 7)], sn = rope[512 + pos * 8 + (r & 7)];
  const float pv = __shfl_xor(v, 8);
  v = v * cs + ((r & 8) ? pv : -pv) * sn;
}

struct EpiIn {
  const Params* p;
  int l;
  DI void operator()(f32x16 (&acc)[2][2], int mrow0, int ncol0, int lane, const float*, bf16_t* st) const {
    const int r = lane & 31, h = lane >> 5;
    const bool latent = mrow0 >= NCTX;
    if (ncol0 != 384 && ncol0 != 1408 && ncol0 + 64 <= IN_COLS) {
#pragma unroll
      for (int j = 0; j < 2; ++j) {
        const float bias = p->b_in[l * IN_COLS + ncol0 + j * 32 + r];
#pragma unroll
        for (int i = 0; i < 2; ++i)
#pragma unroll
          for (int reg = 0; reg < 16; ++reg) acc[i][j][reg] += bias;
      }
      stage_store<2>(acc, st, p->proj + (size_t)mrow0 * PLD + ncol0, PLD, lane);
      return;
    }
    float* sf = (float*)st;
#pragma unroll 1
    for (int j = 0; j < 2; ++j) {
      const int cb = ncol0 + j * 32;
      if (cb >= IN_COLS) continue;
      const int col = cb + r;
      const float bias = (col < IN_COLS) ? p->b_in[l * IN_COLS + col] : 0.f;
#pragma unroll
      for (int i = 0; i < 2; ++i)
#pragma unroll
        for (int reg = 0; reg < 16; ++reg) {
          float v = (j == 0 ? acc[i][0][reg] : acc[i][1][reg]) + bias;
          if (cb == C_KPE && latent) rope_apply(v, p->rope, mrow0 + i * 32 + crow(reg, h), r);
          sf[(i * 32 + crow(reg, h)) * 36 + r] = v;
        }
      asm volatile("s_waitcnt lgkmcnt(0)" ::: "memory");
      {
        const int row = mrow0 + lane;
        bf16_t* pr = p->proj + (size_t)row * PLD + cb;
        float* ok = p->out + O_KPE + ((size_t)((row >> 8) * 4 + l) * 256 + (row & 255)) * 32;
        float* gp = p->gates + (size_t)row * 16;
        const int ncol = (IN_COLS - cb >= 32) ? 32 : 16;
#pragma unroll 1
        for (int q = 0; q < 4; ++q) {
          const float4 a = *(const float4*)(sf + lane * 36 + q * 8);
          const float4 b = *(const float4*)(sf + lane * 36 + q * 8 + 4);
          u32x4 o;
          o[0] = pk_bf16(a.x, a.y); o[1] = pk_bf16(a.z, a.w); o[2] = pk_bf16(b.x, b.y); o[3] = pk_bf16(b.z, b.w);
          if (cb == C_KPE) {
            if (!latent) { *(float4*)(ok + q * 8) = a; *(float4*)(ok + q * 8 + 4) = b; }
            *(u32x4*)(pr + q * 8) = o;
          } else if (cb == C_GATE) {
            if (q < 2) { *(float4*)(gp + q * 8) = a; *(float4*)(gp + q * 8 + 4) = b; }
            else *(u32x4*)(pr + q * 8) = o;
          } else if (q * 8 < ncol) {
            *(u32x4*)(pr + q * 8) = o;
          }
        }
      }
      asm volatile("s_waitcnt lgkmcnt(0)" ::: "memory");
    }
  }
};

struct EpiQ {
  const Params* p;
  DI void operator()(f32x16 (&acc)[2][2], int mrow0, int ncol0, int lane, const float* rsw, bf16_t* st) const {
    const int r = lane & 31, h = lane >> 5;
    const bool latent = mrow0 >= NCTX;
#pragma unroll
    for (int j = 0; j < 2; ++j) {
      const int cb = ncol0 + j * 32;
      const bool pe = (cb % 96) == 64;
#pragma unroll
      for (int i = 0; i < 2; ++i) {
#pragma unroll
        for (int reg = 0; reg < 16; ++reg) {
          const int rl = i * 32 + crow(reg, h);
          float v = acc[i][j][reg] * rsw[rl] * QSCALE;
          if (pe && latent) rope_apply(v, p->rope, mrow0 + rl, r);
          acc[i][j][reg] = v;
        }
      }
    }
    stage_store<2>(acc, st, p->Q + (size_t)mrow0 * 768 + ncol0, 768, lane);
  }
};

struct EpiKV {
  const Params* p;
  DI void operator()(f32x16 (&acc)[2][2], int mrow0, int ncol0, int lane, const float* rsw, bf16_t* st) const {
    const int r = lane & 31, h = lane >> 5;
    if ((ncol0 & 127) == 0) {
#pragma unroll
      for (int i = 0; i < 2; ++i)
#pragma unroll
        for (int j = 0; j < 2; ++j)
#pragma unroll
          for (int reg = 0; reg < 16; ++reg) acc[i][j][reg] *= rsw[i * 32 + crow(reg, h)];
      stage_store<2>(acc, st, p->Kn + ((size_t)mrow0 * 8 + (ncol0 >> 7)) * 64, 512, lane);
      return;
    }
#pragma unroll
    for (int j = 0; j < 2; ++j) {
      const int cb = ncol0 + j * 32;
      const int hd = cb >> 7, within = cb & 127;
#pragma unroll
      for (int i = 0; i < 2; ++i) {
        if (within < 64) {
#pragma unroll
          for (int reg = 0; reg < 16; ++reg) {
            const int rl = i * 32 + crow(reg, h);
            const int row = mrow0 + rl;
            p->Kn[((size_t)row * 8 + hd) * 64 + within + r] = f2bf(acc[i][j][reg] * rsw[rl]);
          }
        } else {
          const int dv = within - 64 + r;
#pragma unroll
          for (int g = 0; g < 4; ++g) {
            const int rl = i * 32 + 8 * g + 4 * h;
            const int row = mrow0 + rl;
            bf16x4 pk;
#pragma unroll
            for (int q = 0; q < 4; ++q) pk[q] = (short)f2bf(acc[i][j][4 * g + q] * rsw[rl + q]);
            bf16_t* dst;
            if (row < NCTX) {
              const int b = row >> 8, key = row & 255;
              dst = p->VtC + ((size_t)((b * 8 + hd) * 64 + dv)) * 256 + key;
            } else if (row < NTOK) {
              const int rr = row - NCTX;
              const int b = rr >> 12, key = rr & 4095;
              dst = p->VtL + ((size_t)((b * 8 + hd) * 64 + dv)) * 4608 + key;
            } else {
              const int rr = row - NTOK;
              const int b = rr >> 9, key = 4096 + (rr & 511);
              dst = p->VtL + ((size_t)((b * 8 + hd) * 64 + dv)) * 4608 + key;
            }
            *(bf16x4*)dst = pk;
          }
        }
      }
    }
  }
};

struct EpiRes {
  const float* src0;
  const float* src1;
  float* dst;
  const float* gate;
  const float2* stats;
  const float* gam;
  const float* bet;
  DI void operator()(f32x16 (&acc)[2][2], int mrow0, int ncol0, int lane, const float*, bf16_t* st) const {
    const int r = lane & 31, h = lane >> 5;
    const float* src = mrow0 < NCTX ? src0 : src1;
    const float* gp = gate + cvec_of(mrow0) * 6144;
    float* sf = (float*)st;
#pragma unroll
    for (int j = 0; j < 2; ++j) {
      const int cb = ncol0 + j * 32;
      const float g = gp[cb + r];
#pragma unroll
      for (int i = 0; i < 2; ++i)
#pragma unroll
        for (int reg = 0; reg < 16; ++reg) sf[(i * 32 + crow(reg, h)) * 36 + r] = g * acc[i][j][reg];
      asm volatile("s_waitcnt lgkmcnt(0)" ::: "memory");
      const int part = lane & 7;
      const int col = cb + part * 4;
      float4 ga = make_float4(1.f, 1.f, 1.f, 1.f), be = make_float4(0.f, 0.f, 0.f, 0.f);
      if (stats) { ga = *(const float4*)(gam + col); be = *(const float4*)(bet + col); }
      float4 xs[8];
      float2 ms[8];
#pragma unroll
      for (int q = 0; q < 8; ++q) {
        const int row = mrow0 + (lane >> 3) + 8 * q;
        xs[q] = *(const float4*)(src + (size_t)row * DM + col);
        ms[q] = stats ? stats[row] : make_float2(0.f, 1.f);
      }
      asm volatile("s_waitcnt vmcnt(0)" ::: "memory");
#pragma unroll
      for (int q = 0; q < 8; ++q) {
        const int rl = (lane >> 3) + 8 * q;
        const float4 a = *(const float4*)(sf + rl * 36 + part * 4);
        float4 x = xs[q];
        if (stats) {
          x.x = (x.x - ms[q].x) * ms[q].y * ga.x + be.x; x.y = (x.y - ms[q].x) * ms[q].y * ga.y + be.y;
          x.z = (x.z - ms[q].x) * ms[q].y * ga.z + be.z; x.w = (x.w - ms[q].x) * ms[q].y * ga.w + be.w;
        }
        float4 y;
        y.x = ALPHA * x.x + a.x; y.y = ALPHA * x.y + a.y; y.z = ALPHA * x.z + a.z; y.w = ALPHA * x.w + a.w;
        *(float4*)(dst + (size_t)(mrow0 + rl) * DM + col) = y;
      }
      asm volatile("s_waitcnt lgkmcnt(0)" ::: "memory");
    }
  }
};

struct EpiFF {
  bf16_t* act;
  DI void operator()(f32x16 (&acc)[2][2], int mrow0, int ncol0, int lane, const float*, bf16_t* st) const {
    const int col0 = (ncol0 >> 6) * 32;
#pragma unroll
    for (int i = 0; i < 2; ++i)
#pragma unroll
      for (int reg = 0; reg < 16; ++reg) acc[i][0][reg] = siluf_(acc[i][0][reg]) * acc[i][1][reg];
    stage_store<1>(acc, st, act + (size_t)mrow0 * PLD + col0, PLD, lane);
  }
};


template <bool PRE, class Epi>
DI void gemm_run(const bf16_t* __restrict__ A, int lda, const bf16_t* __restrict__ Bt, int ldb, int K, int Mt, int Nt,
                 const Epi& epi, char* smem, int bid, int nb) {
  constexpr int BUF = 2 * 128 * 72;
  bf16_t* sbase = (bf16_t*)smem;
  const int tid = tidx(), lane = tid & 63, w = tid >> 6, wm = w >> 1, wn = w & 1;
  const int r = lane & 31, h = lane >> 5;
  const int lrow = tid >> 3, lkc = (tid & 7) * 8;
  int kt = 0, mt, nt;
  if (!tile_map(bid, nb, kt, Mt, Nt, mt, nt)) return;
  const bf16_t* Ap = A + (size_t)(mt * 128 + lrow) * lda + lkc;
  const bf16_t* Bp = Bt + (size_t)(nt * 128 + lrow) * ldb + lkc;
  u32x4 ra0[4], rb0[4], ra1[4], rb1[4];
  auto gl = [&](u32x4* ra, u32x4* rb, int k0) {
#pragma unroll
    for (int i = 0; i < 4; ++i) ra[i] = *(const u32x4*)(Ap + (size_t)i * 32 * lda + k0);
#pragma unroll
    for (int i = 0; i < 4; ++i) rb[i] = *(const u32x4*)(Bp + (size_t)i * 32 * ldb + k0);
  };
  auto lw = [&](const u32x4* ra, const u32x4* rb, int buf) {
    bf16_t* sA = sbase + buf * BUF;
    bf16_t* sB = sA + 128 * 72;
#pragma unroll
    for (int i = 0; i < 4; ++i) *(u32x4*)(sA + (lrow + i * 32) * 72 + lkc) = ra[i];
#pragma unroll
    for (int i = 0; i < 4; ++i) *(u32x4*)(sB + (lrow + i * 32) * 72 + lkc) = rb[i];
  };
  f32x16 acc[2][2];
  auto compute = [&](int buf) {
    const bf16_t* sA = sbase + buf * BUF + (wm * 64 + r) * 72 + 8 * h;
    const bf16_t* sB = sbase + buf * BUF + 128 * 72 + (wn * 64 + r) * 72 + 8 * h;
    bf16x8 fa[2][2], fb[2][2];
#pragma unroll
    for (int i = 0; i < 2; ++i) fa[0][i] = *(const bf16x8*)(sA + i * 32 * 72);
#pragma unroll
    for (int j = 0; j < 2; ++j) fb[0][j] = *(const bf16x8*)(sB + j * 32 * 72);
#pragma unroll
    for (int s4 = 0; s4 < 4; ++s4) {
      const int cur = s4 & 1, nxt = cur ^ 1;
      if (s4 < 3) {
#pragma unroll
        for (int i = 0; i < 2; ++i) fa[nxt][i] = *(const bf16x8*)(sA + i * 32 * 72 + (s4 + 1) * 16);
#pragma unroll
        for (int j = 0; j < 2; ++j) fb[nxt][j] = *(const bf16x8*)(sB + j * 32 * 72 + (s4 + 1) * 16);
      }
      __builtin_amdgcn_sched_barrier(0);
#pragma unroll
      for (int i = 0; i < 2; ++i)
#pragma unroll
        for (int j = 0; j < 2; ++j) acc[i][j] = mfma(fa[cur][i], fb[cur][j], acc[i][j]);
      __builtin_amdgcn_sched_barrier(0);
    }
  };
  gl(ra0, rb0, 0);
  gl(ra1, rb1, 64);
  for (;;) {
#pragma unroll
    for (int i = 0; i < 2; ++i)
#pragma unroll
      for (int j = 0; j < 2; ++j) acc[i][j] = zero16();
    __syncthreads();
    lw(ra0, rb0, 0);
    if (128 < K) gl(ra0, rb0, 128);
    __syncthreads();
    for (int k0 = 0; k0 < K; k0 += 128) {
      lw(ra1, rb1, 1);
      if (k0 + 192 < K) gl(ra1, rb1, k0 + 192);
      compute(0);
      __syncthreads();
      if (k0 + 128 < K) {
        lw(ra0, rb0, 0);
        if (k0 + 256 < K) gl(ra0, rb0, k0 + 256);
      }
      compute(1);
      __syncthreads();
    }
    const int m0 = mt * 128, n0 = nt * 128;
    const bool more = tile_map(bid, nb, ++kt, Mt, Nt, mt, nt);
    if (PRE && more) {
      Ap = A + (size_t)(mt * 128 + lrow) * lda + lkc;
      Bp = Bt + (size_t)(nt * 128 + lrow) * ldb + lkc;
      gl(ra0, rb0, 0);
      gl(ra1, rb1, 64);
    }
    epi(acc, m0 + wm * 64, n0 + wn * 64, lane, (const float*)nullptr, (bf16_t*)smem + w * (64 * 72));
    if (!more) break;
    if (!PRE) {
      Ap = A + (size_t)(mt * 128 + lrow) * lda + lkc;
      Bp = Bt + (size_t)(nt * 128 + lrow) * ldb + lkc;
      gl(ra0, rb0, 0);
      gl(ra1, rb1, 64);
    }
  }
}

DI void convert_tile(const float* __restrict__ W, bf16_t* __restrict__ Wt, int ldw, int K, int N, int mode,
                     const float* __restrict__ g, int kt, int nt, char* smem) {
  float* s = (float*)smem;
  const int tid = tidx(), tx = tid & 63, ty = tid >> 6;
  const int k0 = kt * 64, n0 = nt * 64;
  int src;
  if (mode == 1) src = (tx < 32) ? (nt * 32 + tx) : (FFD + nt * 32 + tx - 32);
  else src = n0 + tx;
  __syncthreads();
#pragma unroll
  for (int i = 0; i < 16; ++i) {
    const int k = ty + 4 * i;
    float v = (src < N) ? W[(size_t)(k0 + k) * N + src] : 0.f;
    if (g) v *= g[k0 + k];
    s[k * 65 + tx] = v;
  }
  __syncthreads();
#pragma unroll
  for (int i = 0; i < 16; ++i) {
    const int n = ty + 4 * i;
    Wt[(size_t)(n0 + n) * ldw + k0 + tx] = f2bf(s[tx * 65 + n]);
  }
}

DI void convert_layer(const Params& p, int l, int bid, int nb, char* smem) {
  for (int it = bid; it < 3152; it += nb) {
    int t = it;
    if (t < 704) { convert_tile(p.w_in + (size_t)l * 1024 * IN_COLS, p.wb_in, HLD, 1024, IN_COLS, 0, nullptr, t % 16, t / 16, smem); continue; }
    t -= 704;
    if (t < 48) { convert_tile(p.w_uq + (size_t)l * 256 * 768, p.wb_uq, 256, 256, 768, 0, p.q_norm + l * 256, t % 4, t / 4, smem); continue; }
    t -= 48;
    if (t < 32) { convert_tile(p.w_ukv + (size_t)l * 128 * 1024, p.wb_ukv, 128, 128, 1024, 0, p.kv_norm + l * 128, t % 2, t / 2, smem); continue; }
    t -= 32;
    if (t < 256) { convert_tile(p.w_out + (size_t)l * 1024 * 1024, p.wb_out, HLD, 1024, 1024, 0, nullptr, t % 16, t / 16, smem); continue; }
    t -= 256;
    if (t < 1408) { convert_tile(p.w_ffi + (size_t)l * 1024 * 5632, p.wb_ffi, HLD, 1024, 5632, 1, nullptr, t % 16, t / 16, smem); continue; }
    t -= 1408;
    convert_tile(p.w_ffo + (size_t)l * FFD * 1024, p.wb_ffo, PLD, FFD, 1024, 0, nullptr, t % 44, t / 44, smem);
  }
}

DI void phase0_misc(const Params& p, int bid, int nb, char* smem) {
  const int tid = tidx();
  if (bid < 384) {
    float* sc = (float*)smem;
    float* red = sc + 5 * 1024;
    __syncthreads();
    for (int e = tid; e < 5 * 1024; e += 256) {
      const int v = e >> 10, k = e & 1023;
      const float x = v == 0 ? p.c_ctx[k] : p.c[(v - 1) * 1024 + k];
      sc[e] = siluf_(x);
    }
    __syncthreads();
    for (int it = bid; it < 384; it += nb) {
      const int l = it / 96, n0 = (it % 96) * 64;
      const int col = tid & 63, ks = tid >> 6;
      float a[5] = {0.f, 0.f, 0.f, 0.f, 0.f};
      const float* wp = p.w_mod + (size_t)l * 1024 * 6144 + n0 + col;
      for (int k = ks * 256; k < ks * 256 + 256; ++k) {
        const float wv = wp[(size_t)k * 6144];
#pragma unroll
        for (int v = 0; v < 5; ++v) a[v] += sc[v * 1024 + k] * wv;
      }
      __syncthreads();
#pragma unroll
      for (int v = 0; v < 5; ++v) red[(ks * 5 + v) * 64 + col] = a[v];
      __syncthreads();
      for (int e = tid; e < 320; e += 256) {
        const int v = e >> 6, cc = e & 63;
        const float sum = red[(0 * 5 + v) * 64 + cc] + red[(1 * 5 + v) * 64 + cc] + red[(2 * 5 + v) * 64 + cc] +
                          red[(3 * 5 + v) * 64 + cc];
        p.modv[((size_t)l * 5 + v) * 6144 + n0 + cc] = sum + p.b_mod[l * 6144 + n0 + cc];
      }
    }
  }
  const int gt = bid * 256 + tid, gn = nb * 256;
  for (int c = gt; c < 256; c += gn) {
    float x[4], mx = -1e30f;
    for (int l = 0; l < 4; ++l) { x[l] = p.lb_logits[l * 256 + c]; mx = fmaxf(mx, x[l]); }
    float s = 0.f;
    for (int l = 0; l < 4; ++l) { x[l] = __expf(x[l] - mx); s += x[l]; }
    float cum = 0.f;
    for (int l = 0; l < 4; ++l) {
      const float pl = x[l] / s;
      if (l > 0) cum += pl;
      p.lbs[l * 256 + c] = cum;
    }
  }
  for (int e = gt; e < 512; e += gn) {
    const int pos = e >> 3, i = e & 7;
    const float f = exp2f(-(float)i * 0.125f * 13.287712379549449f);
    const float ang = (float)pos * f;
    p.rope[e] = __cosf(ang);
    p.rope[512 + e] = __sinf(ang);
  }
  for (int e = gt; e < 4 * 4 * 512 * 128; e += gn) {
    const int k = e & 127, t = (e >> 7) & 511, b = (e >> 16) & 3, l = e >> 18;
    const float cv = p.cache_ckv[(((size_t)b * 4 + l) * 512 + t) * 128 + k] / p.kv_norm[l * 128 + k];
    asm volatile("s_waitcnt vmcnt(0)" ::: "memory");
    p.ckvc[e] = f2bf(cv);
  }
  for (int e = gt; e < 4 * 4 * 512 * 32; e += gn) {
    const int k = e & 31, t = (e >> 5) & 511, b = (e >> 14) & 3, l = e >> 16;
    const float kv = p.cache_kpe[(((size_t)b * 4 + l) * 512 + t) * 32 + k];
    asm volatile("s_waitcnt vmcnt(0)" ::: "memory");
    p.kpec[e] = f2bf(kv);
  }
}

DI void phase0_h(const Params& p, int bid, int nb) {
  const int tid = tidx(); const int lane = tid & 63, gw = bid * 4 + (tid >> 6), nw = nb * 4;
  for (int row = gw; row < NTOK; row += nw) {
    const float* src = row < NCTX ? p.x_prompt + (size_t)row * DM : p.x_sample + (size_t)(row - NCTX) * DM;
    const float* mv = p.modv + (size_t)cvec_of(row) * 6144;
    float4 x[4], sh[4], sc[4];
#pragma unroll
    for (int i = 0; i < 4; ++i) {
      const int col = i * 256 + lane * 4;
      x[i] = *(const float4*)(src + col);
      sh[i] = *(const float4*)(mv + col);
      sc[i] = *(const float4*)(mv + 1024 + col);
    }
    asm volatile("s_waitcnt vmcnt(0)" ::: "memory");
#pragma unroll
    for (int i = 0; i < 4; ++i) {
      const int col = i * 256 + lane * 4;
      bf16x4 o;
      o[0] = (short)f2bf(x[i].x * (1.f + sc[i].x) + sh[i].x);
      o[1] = (short)f2bf(x[i].y * (1.f + sc[i].y) + sh[i].y);
      o[2] = (short)f2bf(x[i].z * (1.f + sc[i].z) + sh[i].z);
      o[3] = (short)f2bf(x[i].w * (1.f + sc[i].w) + sh[i].w);
      *(bf16x4*)(p.hbuf + (size_t)row * HLD + col) = o;
    }
  }
}

DI float wave_sum(float v) {
#pragma unroll
  for (int o = 32; o > 0; o >>= 1) v += __shfl_xor(v, o);
  return v;
}
DI float wave_max(float v) {
#pragma unroll
  for (int o = 32; o > 0; o >>= 1) v = fmaxf(v, __shfl_xor(v, o));
  return v;
}

DI void ln_phase(const Params& p, int l, int which, int bid, int nb) {
  const int tid = tidx(); const int lane = tid & 63, gw = bid * 4 + (tid >> 6), nw = nb * 4;
  float* X = which == 1 ? p.X1 : p.out;
  float2* S = which == 1 ? p.S1 : p.S2;
  const float* gam = (which == 1 ? p.ln1_g : p.ln2_g) + l * DM;
  const float* bet = (which == 1 ? p.ln1_b : p.ln2_b) + l * DM;
  const bool wh = which == 1 || l < 3;
  const bool wx = which == 2 && l == 3;
  const int ml = which == 1 ? l : l + 1;
  const int shoff = which == 1 ? 3072 : 0;
  auto process = [&](float4 (&x)[4], int row) {
    float* xr = X + (size_t)row * DM;
    float s = 0.f;
#pragma unroll
    for (int i = 0; i < 4; ++i) s += x[i].x + x[i].y + x[i].z + x[i].w;
    const float mu = wave_sum(s) * (1.f / 1024.f);
    float v = 0.f;
#pragma unroll
    for (int i = 0; i < 4; ++i) {
      x[i].x -= mu; x[i].y -= mu; x[i].z -= mu; x[i].w -= mu;
      v += x[i].x * x[i].x + x[i].y * x[i].y + x[i].z * x[i].z + x[i].w * x[i].w;
    }
    const float rstd = rsqrtf(wave_sum(v) * (1.f / 1024.f) + EPSF);
    if (lane == 0) S[row] = make_float2(mu, rstd);
    const float* mv = p.modv + ((size_t)ml * 5 + cvec_of(row)) * 6144 + shoff;
#pragma unroll
    for (int i = 0; i < 4; ++i) {
      const int col = i * 256 + lane * 4;
      const float4 g = *(const float4*)(gam + col), b = *(const float4*)(bet + col);
      float4 y;
      y.x = x[i].x * rstd * g.x + b.x; y.y = x[i].y * rstd * g.y + b.y;
      y.z = x[i].z * rstd * g.z + b.z; y.w = x[i].w * rstd * g.w + b.w;
      if (wx) *(float4*)(xr + col) = y;
      if (wh) {
        const float4 sh = *(const float4*)(mv + col), sc = *(const float4*)(mv + 1024 + col);
        bf16x4 o;
        o[0] = (short)f2bf(y.x * (1.f + sc.x) + sh.x);
        o[1] = (short)f2bf(y.y * (1.f + sc.y) + sh.y);
        o[2] = (short)f2bf(y.z * (1.f + sc.z) + sh.z);
        o[3] = (short)f2bf(y.w * (1.f + sc.w) + sh.w);
        *(bf16x4*)(p.hbuf + (size_t)row * HLD + col) = o;
      }
    }
  };
  for (int row = gw; row < NTOK; row += 2 * nw) {
    const int row2 = row + nw;
    const bool has2 = row2 < NTOK;
    float4 xa[4], xb[4];
#pragma unroll
    for (int i = 0; i < 4; ++i) xa[i] = *(const float4*)(X + (size_t)row * DM + i * 256 + lane * 4);
    if (has2) {
#pragma unroll
      for (int i = 0; i < 4; ++i) xb[i] = *(const float4*)(X + (size_t)row2 * DM + i * 256 + lane * 4);
    }
    asm volatile("s_waitcnt vmcnt(0)" ::: "memory");
    process(xa, row);
    if (has2) process(xb, row2);
  }
}

DI int scan_idx(int dir, int hd, int tc) { return (dir * 4 + hd) * NTC + tc; }

DI void mlstm_local(const Params& p, int tc, int hd, char* smem) {
  bf16_t* sKT = (bf16_t*)smem;
  bf16_t* sVT = sKT + 2 * 64 * 72;
  float* sW = (float*)(sVT + 64 * 72);
  const int tid = tidx(), lane = tid & 63, w = tid >> 6;
  const int row0 = tc * 64;
  __syncthreads();
  if (w < 2) {
    const int dir = w;
    const int t = dir ? 63 - lane : lane;
    const float* gp = p.gates + (size_t)(row0 + t) * 16;
    const float ig = gp[dir * 4 + hd], fg = gp[8 + dir * 4 + hd];
    const float lf = fminf(fg, 0.f) - log1pf(__expf(-fabsf(fg)));
    float b = lf;
#pragma unroll
    for (int o = 1; o < 64; o <<= 1) {
      const float v = __shfl_up(b, o);
      if (lane >= o) b += v;
    }
    const float g = __shfl(b, 63);
    const float u = g - b + ig;
    const float um = wave_max(u);
    sW[dir * 64 + t] = __expf(u - um);
    if (lane == 0) {
      p.Mg[scan_idx(dir, hd, tc)] = g;
      p.Mumax[scan_idx(dir, hd, tc)] = um;
    }
  }
  __syncthreads();
  {
    const int t = tid >> 2, c0 = (tid & 3) * 16;
    const bf16_t* kp = p.proj + (size_t)(row0 + t) * PLD + C_MK + hd * 64 + c0;
    const bf16_t* vp = p.proj + (size_t)(row0 + t) * PLD + C_MV + hd * 64 + c0;
    const float w0 = sW[t], w1 = sW[64 + t];
#pragma unroll
    for (int q = 0; q < 2; ++q) {
      const bf16x8 kv = *(const bf16x8*)(kp + q * 8);
      const bf16x8 vv = *(const bf16x8*)(vp + q * 8);
#pragma unroll
      for (int j = 0; j < 8; ++j) {
        const int d = c0 + q * 8 + j;
        const float kf = bfs(kv[j]) * 0.125f;
        sKT[d * 72 + t] = f2bf(kf * w0);
        sKT[64 * 72 + d * 72 + t] = f2bf(kf * w1);
        sVT[d * 72 + t] = (bf16_t)vv[j];
      }
    }
  }
  __syncthreads();
  if (tid < 128) {
    const int dir = tid >> 6, d = tid & 63;
    float s = 0.f;
    for (int t = 0; t < 64; ++t) s += bf2f(sKT[dir * 64 * 72 + d * 72 + t]);
    p.Mn[(size_t)scan_idx(dir, hd, tc) * 64 + d] = s;
  }
  const int I = w >> 1, J = w & 1, r = lane & 31, h = lane >> 5;
#pragma unroll
  for (int dir = 0; dir < 2; ++dir) {
    f32x16 acc = zero16();
    wave_mma1(acc, sKT + dir * 64 * 72 + I * 32 * 72, 72, sVT + J * 32 * 72, 72, 64, lane);
    bf16_t* U = p.MU + (size_t)scan_idx(dir, hd, tc) * 4096;
#pragma unroll
    for (int reg = 0; reg < 16; ++reg) U[(I * 32 + crow(reg, h)) * 64 + J * 32 + r] = f2bf(acc[reg]);
  }
}

DI void state_item(const Params& p, int l, int item) {
  const int tid = tidx();
  const bool hg = item >= 576;
  if (hg) item -= 576;
  const int part = item & 1;
  int chain = item >> 1;
  chain = chain < 32 ? chain + 256 : chain - 32;
  const int hd = chain & 3, dir = (chain >> 2) & 1, seq = chain >> 3;
  const int e0 = (part * 256 + tid) * 8;
  const bool ctx = seq < 32;
  const int b = ctx ? seq : seq - 32;
  const int nc = ctx ? 4 : 64;
  const int tcb = ctx ? seq * 4 : 128 + b * 64;
  const int sidx = ((b * 4 + l) * 2 + dir) * 4 + hd;
  bf16_t* U = hg ? p.HU : p.MU;
  const bool don = (!hg) && part == 0 && tid < 8;
  float C[8], n[8], m = 0.f;
#pragma unroll
  for (int j = 0; j < 8; ++j) { C[j] = 0.f; n[j] = 0.f; }
  if (!ctx) {
    const float* src = (hg ? p.st_S : p.st_C) + (size_t)sidx * 4096 + e0;
    const float4 c0 = *(const float4*)src, c1 = *(const float4*)(src + 4);
    C[0] = c0.x; C[1] = c0.y; C[2] = c0.z; C[3] = c0.w; C[4] = c1.x; C[5] = c1.y; C[6] = c1.z; C[7] = c1.w;
    if (!hg) {
      m = p.st_m[sidx];
      if (don) {
#pragma unroll
        for (int j = 0; j < 8; ++j) n[j] = p.st_n[sidx * 64 + tid * 8 + j];
      }
    }
  }
  const int crow_ = e0 >> 6;
  for (int c0 = 0; c0 < nc; c0 += 4) {
    u32x4 u[4];
    float g[4], um[4];
    int idx[4];
#pragma unroll
    for (int q = 0; q < 4; ++q) {
      const int c = c0 + q;
      const int tc = dir ? tcb + nc - 1 - c : tcb + c;
      idx[q] = scan_idx(dir, hd, tc);
      u[q] = *(const u32x4*)(U + (size_t)idx[q] * 4096 + e0);
      if (hg) {
        g[q] = p.Hd[(size_t)idx[q] * 64 + crow_];
        um[q] = 0.f;
      } else {
        g[q] = p.Mg[idx[q]];
        um[q] = p.Mumax[idx[q]];
      }
    }
#pragma unroll
    for (int q = 0; q < 4; ++q) {
      u32x4 o;
#pragma unroll
      for (int j = 0; j < 4; ++j) o[j] = (unsigned)f2bf(C[2 * j]) | ((unsigned)f2bf(C[2 * j + 1]) << 16);
      *(u32x4*)(U + (size_t)idx[q] * 4096 + e0) = o;
      float uf[8];
#pragma unroll
      for (int j = 0; j < 4; ++j) { uf[2 * j] = __uint_as_float(u[q][j] << 16); uf[2 * j + 1] = __uint_as_float(u[q][j] & 0xffff0000u); }
      if (hg) {
#pragma unroll
        for (int j = 0; j < 8; ++j) C[j] = g[q] * C[j] + uf[j];
      } else {
        const float mnew = fmaxf(g[q] + m, um[q]);
        const float sc = __expf(g[q] + m - mnew), su = __expf(um[q] - mnew);
        if (don) {
          float* np = p.Mn + (size_t)idx[q] * 64 + tid * 8;
#pragma unroll
          for (int j = 0; j < 8; ++j) { const float nl = np[j]; np[j] = n[j]; n[j] = sc * n[j] + su * nl; }
        }
        if (part == 0 && tid == 0) p.Mm[idx[q]] = m;
#pragma unroll
        for (int j = 0; j < 8; ++j) C[j] = sc * C[j] + su * uf[j];
        m = mnew;
      }
    }
  }
  if (ctx) {
    float* dst = p.out + (hg ? O_S : O_C) + (size_t)sidx * 4096 + e0;
    *(float4*)dst = make_float4(C[0], C[1], C[2], C[3]);
    *(float4*)(dst + 4) = make_float4(C[4], C[5], C[6], C[7]);
    if (!hg) {
      if (don) {
#pragma unroll
        for (int j = 0; j < 8; ++j) p.out[O_N + sidx * 64 + tid * 8 + j] = n[j];
      }
      if (part == 0 && tid == 0) p.out[O_M + sidx] = m;
    }
  }
}

DI void mlstm_out(const Params& p, int l, int tc, int hd, char* smem) {
  bf16_t* sQ = (bf16_t*)smem;
  bf16_t* sK = sQ + 64 * 72;
  bf16_t* sVT = sK + 64 * 72;
  bf16_t* sCT = sVT + 64 * 72;
  bf16_t* sP = sCT + 64 * 72;
  float* fb = (float*)(sP + 64 * 72);
  float *sb = fb, *sib = fb + 64, *smt = fb + 128, *sws = fb + 192, *sden = fb + 256, *sn = fb + 320;
  float* sH = (float*)smem;
  const int tid = tidx(), lane = tid & 63, w = tid >> 6;
  const int I = w >> 1, J = w & 1, r = lane & 31, h = lane >> 5;
  const int row0 = tc * 64;
  __syncthreads();
  {
    const int t = tid >> 2, c0 = (tid & 3) * 16;
    const bf16_t* qp = p.proj + (size_t)(row0 + t) * PLD + C_MQ + hd * 64 + c0;
    const bf16_t* kp = p.proj + (size_t)(row0 + t) * PLD + C_MK + hd * 64 + c0;
    const bf16_t* vp = p.proj + (size_t)(row0 + t) * PLD + C_MV + hd * 64 + c0;
#pragma unroll
    for (int q = 0; q < 2; ++q) {
      *(bf16x8*)(sQ + t * 72 + c0 + q * 8) = *(const bf16x8*)(qp + q * 8);
      const bf16x8 kv = *(const bf16x8*)(kp + q * 8);
      const bf16x8 vv = *(const bf16x8*)(vp + q * 8);
#pragma unroll
      for (int j = 0; j < 8; ++j) {
        const int d = c0 + q * 8 + j;
        sK[t * 72 + d] = f2bf(bfs(kv[j]) * 0.125f);
        sVT[d * 72 + t] = (bf16_t)vv[j];
      }
    }
  }
  f32x16 hacc = zero16();
  for (int dir = 0; dir < 2; ++dir) {
    const int idx = scan_idx(dir, hd, tc);
    if (w == 0) {
      const int t = dir ? 63 - lane : lane;
      const float* gp = p.gates + (size_t)(row0 + t) * 16;
      const float ig = gp[dir * 4 + hd], fg = gp[8 + dir * 4 + hd];
      const float lf = fminf(fg, 0.f) - log1pf(__expf(-fabsf(fg)));
      float b = lf;
#pragma unroll
      for (int o = 1; o < 64; o <<= 1) {
        const float v = __shfl_up(b, o);
        if (lane >= o) b += v;
      }
      const float ib = ig - b;
      float pm = ib;
#pragma unroll
      for (int o = 1; o < 64; o <<= 1) {
        const float v = __shfl_up(pm, o);
        if (lane >= o) pm = fmaxf(pm, v);
      }
      const float m0 = p.Mm[idx];
      const float mt = fmaxf(b + m0, b + pm);
      sb[t] = b; sib[t] = ib; smt[t] = mt; sws[t] = __expf(b + m0 - mt);
    } else {
      const bf16_t* Cs = p.MU + (size_t)idx * 4096;
      for (int e = tid - 64; e < 4096; e += 192) {
        const int d = e >> 6, ee = e & 63;
        sCT[ee * 72 + d] = Cs[e];
      }
      if (w == 1) sn[lane] = p.Mn[(size_t)idx * 64 + lane];
    }
    __syncthreads();
    const bool skip = dir ? (I == 1 && J == 0) : (I == 0 && J == 1);
    {
      f32x16 s = zero16();
      if (!skip) wave_mma1(s, sQ + I * 32 * 72, 72, sK + J * 32 * 72, 72, 64, lane);
      const int sg = J * 32 + r;
      const float ibs = sib[sg];
#pragma unroll
      for (int reg = 0; reg < 16; ++reg) {
        const int t = I * 32 + crow(reg, h);
        const bool keep = dir ? (sg >= t) : (sg <= t);
        const float pv = keep ? s[reg] * __expf(sb[t] + ibs - smt[t]) : 0.f;
        sP[t * 72 + sg] = f2bf(pv);
      }
    }
    f32x16 acc = zero16();
    wave_mma1(acc, sQ + I * 32 * 72, 72, sCT + J * 32 * 72, 72, 64, lane);
#pragma unroll
    for (int reg = 0; reg < 16; ++reg) acc[reg] *= sws[I * 32 + crow(reg, h)];
    __syncthreads();
    if (tid < 64) {
      const int t = tid;
      float qn = 0.f, ps = 0.f;
      for (int d = 0; d < 64; ++d) {
        qn += bf2f(sQ[t * 72 + d]) * sn[d];
        ps += bf2f(sP[t * 72 + d]);
      }
      const float den = sws[t] * qn + ps;
      sden[t] = __builtin_amdgcn_rcpf(fmaxf(fabsf(den), __expf(-smt[t])));
    }
    wave_mma1(acc, sP + I * 32 * 72, 72, sVT + J * 32 * 72, 72, 64, lane);
    __syncthreads();
#pragma unroll
    for (int reg = 0; reg < 16; ++reg) hacc[reg] += acc[reg] * sden[I * 32 + crow(reg, h)];
    __syncthreads();
  }
#pragma unroll
  for (int reg = 0; reg < 16; ++reg) sH[(I * 32 + crow(reg, h)) * 64 + J * 32 + r] = hacc[reg];
  __syncthreads();
  {
    const int t = tid >> 2, c0 = (tid & 3) * 16;
    float v[16], s = 0.f;
#pragma unroll
    for (int j = 0; j < 16; ++j) { v[j] = sH[t * 64 + c0 + j]; s += v[j]; }
    s += __shfl_xor(s, 1); s += __shfl_xor(s, 2);
    const float mu = s * (1.f / 64.f);
    float q = 0.f;
#pragma unroll
    for (int j = 0; j < 16; ++j) { v[j] -= mu; q += v[j] * v[j]; }
    q += __shfl_xor(q, 1); q += __shfl_xor(q, 2);
    const float rstd = rsqrtf(q * (1.f / 64.f) + EPSF);
    const bf16_t* mo = p.proj + (size_t)(row0 + t) * PLD + C_MO + hd * 64 + c0;
    const float* ng = p.ml_norm + l * 256 + hd * 64 + c0;
    bf16_t* dst = p.hbuf + (size_t)(row0 + t) * HLD + 512 + hd * 64 + c0;
    const bf16x8 mv0 = *(const bf16x8*)(mo), mv1 = *(const bf16x8*)(mo + 8);
    float ngv[16];
#pragma unroll
    for (int j = 0; j < 16; ++j) ngv[j] = ng[j];
    asm volatile("s_waitcnt vmcnt(0)" ::: "memory");
#pragma unroll
    for (int q2 = 0; q2 < 2; ++q2) {
      const bf16x8 mv = q2 ? mv1 : mv0;
      bf16x8 o;
#pragma unroll
      for (int j = 0; j < 8; ++j)
        o[j] = (short)f2bf(v[q2 * 8 + j] * rstd * ngv[q2 * 8 + j] * sigmoidf_(bfs(mv[j])));
      *(bf16x8*)(dst + q2 * 8) = o;
    }
  }
}

DI void hgrn_gate(float fr, float lbv, float& kk, float& lg) {
  const float sg = sigmoidf_(fr);
  const float f = lbv + (1.f - lbv) * sg;
  kk = (1.f - lbv) * sigmoidf_(-fr);
  lg = __logf(fmaxf(f, 1e-30f));
}

DI float hgrn_cumsum(float* sBc, float* sTot, int dir, int tid, float* ref31) {
  const int c = tid & 63, seg = tid >> 6;
  float v[16];
#pragma unroll
  for (int i = 0; i < 16; ++i) {
    const int sp = seg * 16 + i;
    const int tt = dir ? 63 - sp : sp;
    v[i] = sBc[tt * 64 + c];
  }
  float run = 0.f;
#pragma unroll
  for (int i = 0; i < 16; ++i) { run += v[i]; v[i] = run; }
  sTot[seg * 64 + c] = run;
  __syncthreads();
  const float t0 = sTot[c], t1 = sTot[64 + c], t2 = sTot[128 + c], t3 = sTot[192 + c];
  const float off = (seg > 0 ? t0 : 0.f) + (seg > 1 ? t1 : 0.f) + (seg > 2 ? t2 : 0.f);
#pragma unroll
  for (int i = 0; i < 16; ++i) {
    const int sp = seg * 16 + i;
    const int tt = dir ? 63 - sp : sp;
    sBc[tt * 64 + c] = v[i] + off;
  }
  *ref31 = v[15] + off;
  return ((t0 + t1) + t2) + t3;
}

DI void hgrn_local(const Params& p, int l, int tc, int hd, char* smem) {
  float* sBc = (float*)smem;
  bf16_t* sKG = (bf16_t*)(sBc + 4096);
  bf16_t* sVT = sKG + 64 * 72;
  float* sGL = (float*)(sVT + 64 * 72);
  const int tid = tidx(), lane = tid & 63, w = tid >> 6;
  const int I = w >> 1, J = w & 1, r = lane & 31, h = lane >> 5;
  const int row0 = tc * 64;
  const int t = tid >> 2, c0 = (tid & 3) * 16;
  __syncthreads();
  {
    const bf16_t* vp = p.proj + (size_t)(row0 + t) * PLD + C_GI + hd * 64 + c0;
#pragma unroll
    for (int q = 0; q < 2; ++q) {
      const bf16x8 vv = *(const bf16x8*)(vp + q * 8);
#pragma unroll
      for (int j = 0; j < 8; ++j) sVT[(c0 + q * 8 + j) * 72 + t] = (bf16_t)vv[j];
    }
  }
  for (int dir = 0; dir < 2; ++dir) {
    const int idx = scan_idx(dir, hd, tc);
    float kk[16];
    {
      const bf16_t* fp = p.proj + (size_t)(row0 + t) * PLD + (dir ? C_GFB : C_GFF) + hd * 64 + c0;
      const float* lbp = p.lbs + l * 256 + hd * 64 + c0;
#pragma unroll
      for (int q = 0; q < 2; ++q) {
        const bf16x8 fv = *(const bf16x8*)(fp + q * 8);
#pragma unroll
        for (int j = 0; j < 8; ++j) {
          float lg;
          hgrn_gate(bfs(fv[j]), lbp[q * 8 + j], kk[q * 8 + j], lg);
          sBc[t * 64 + c0 + q * 8 + j] = lg;
        }
      }
    }
    __syncthreads();
    {
      float r31;
      const float tot = hgrn_cumsum(sBc, sGL + 64, dir, tid, &r31);
      if (tid < 64) {
        sGL[tid] = tot;
        p.Hd[(size_t)idx * 64 + tid] = __expf(tot);
      }
    }
    __syncthreads();
#pragma unroll
    for (int j = 0; j < 16; ++j) {
      const int c = c0 + j;
      sKG[c * 72 + t] = f2bf(kk[j] * __expf(sGL[c] - sBc[t * 64 + c]));
    }
    __syncthreads();
    f32x16 acc = zero16();
    wave_mma1(acc, sKG + I * 32 * 72, 72, sVT + J * 32 * 72, 72, 64, lane);
    bf16_t* U = p.HU + (size_t)idx * 4096;
#pragma unroll
    for (int reg = 0; reg < 16; ++reg) U[(I * 32 + crow(reg, h)) * 64 + J * 32 + r] = f2bf(acc[reg]);
    __syncthreads();
  }
}

DI void hgrn_out(const Params& p, int l, int tc, int hd, char* smem) {
  float* sBc = (float*)smem;
  bf16_t* sVT = (bf16_t*)(sBc + 4096);
  bf16_t* sST = sVT + 64 * 72;
  bf16_t* sQ = sST + 64 * 72;
  bf16_t* sQ1 = sQ + 64 * 72;
  bf16_t* sK = sQ1 + 32 * 72;
  bf16_t* sK1 = sK + 64 * 72;
  float* sRef = (float*)(sK1 + 32 * 72);
  const int tid = tidx(), lane = tid & 63, w = tid >> 6;
  const int I = w >> 1, J = w & 1, r = lane & 31, h = lane >> 5;
  const int row0 = tc * 64;
  const int t = tid >> 2, c0 = (tid & 3) * 16;
  __syncthreads();
  {
    const bf16_t* vp = p.proj + (size_t)(row0 + t) * PLD + C_GI + hd * 64 + c0;
#pragma unroll
    for (int q = 0; q < 2; ++q) {
      const bf16x8 vv = *(const bf16x8*)(vp + q * 8);
#pragma unroll
      for (int j = 0; j < 8; ++j) sVT[(c0 + q * 8 + j) * 72 + t] = (bf16_t)vv[j];
    }
  }
  f32x16 oacc = zero16();
  for (int dir = 0; dir < 2; ++dir) {
    const int idx = scan_idx(dir, hd, tc);
    float kk[16], qv[16];
    {
      const bf16_t* fp = p.proj + (size_t)(row0 + t) * PLD + (dir ? C_GFB : C_GFF) + hd * 64 + c0;
      const bf16_t* qp = p.proj + (size_t)(row0 + t) * PLD + C_GQ + hd * 64 + c0;
      const float* lbp = p.lbs + l * 256 + hd * 64 + c0;
#pragma unroll
      for (int q = 0; q < 2; ++q) {
        const bf16x8 fv = *(const bf16x8*)(fp + q * 8);
        const bf16x8 qq = *(const bf16x8*)(qp + q * 8);
#pragma unroll
        for (int j = 0; j < 8; ++j) {
          float lg;
          hgrn_gate(bfs(fv[j]), lbp[q * 8 + j], kk[q * 8 + j], lg);
          sBc[t * 64 + c0 + q * 8 + j] = lg;
          qv[q * 8 + j] = siluf_(bfs(qq[j]));
        }
      }
      const bf16_t* Ss = p.HU + (size_t)idx * 4096;
#pragma unroll
      for (int i = 0; i < 16; ++i) {
        const int e = i * 256 + tid;
        sST[(e & 63) * 72 + (e >> 6)] = Ss[e];
      }
    }
    __syncthreads();
    {
      float r31;
      (void)hgrn_cumsum(sBc, sRef + 64, dir, tid, &r31);
      if ((tid >> 6) == 1) sRef[tid & 63] = r31;
    }
    __syncthreads();
    const int sb2 = dir ? 0 : 1;
    {
      const bool second = (t >> 5) == sb2;
#pragma unroll
      for (int j = 0; j < 16; ++j) {
        const int c = c0 + j;
        const float bc = sBc[t * 64 + c];
        const float rf = sRef[c];
        sQ[t * 72 + c] = f2bf(qv[j] * __expf(bc));
        if (second) {
          sQ1[(t & 31) * 72 + c] = f2bf(qv[j] * __expf(bc - rf));
          sK[t * 72 + c] = f2bf(kk[j] * __expf(rf - bc));
        } else {
          sK[t * 72 + c] = f2bf(kk[j] * __expf(-bc));
          sK1[(t & 31) * 72 + c] = f2bf(kk[j] * __expf(rf - bc));
        }
      }
    }
    __syncthreads();
    f32x16 a = zero16();
    if (I == J) {
      wave_mma1(a, (I == sb2) ? sQ1 : sQ + I * 32 * 72, 72, sK + J * 32 * 72, 72, 64, lane);
#pragma unroll
      for (int reg = 0; reg < 16; ++reg) {
        const int tl = crow(reg, h);
        const bool keep = dir ? (r >= tl) : (r <= tl);
        if (!keep) a[reg] = 0.f;
      }
    } else if (I == sb2) {
      wave_mma1(a, sQ1, 72, sK1, 72, 64, lane);
    }
    wave_mma1(oacc, sQ + I * 32 * 72, 72, sST + J * 32 * 72, 72, 64, lane);
    __syncthreads();
#pragma unroll
    for (int reg = 0; reg < 16; ++reg) sQ[(I * 32 + crow(reg, h)) * 72 + J * 32 + r] = f2bf(a[reg]);
    __syncthreads();
    wave_mma1(oacc, sQ + I * 32 * 72, 72, sVT + J * 32 * 72, 72, 64, lane);
    __syncthreads();
  }
  float* sO = sBc;
#pragma unroll
  for (int reg = 0; reg < 16; ++reg) sO[(I * 32 + crow(reg, h)) * 64 + J * 32 + r] = oacc[reg];
  __syncthreads();
  {
    float v[16], q = 0.f;
#pragma unroll
    for (int j = 0; j < 16; ++j) { v[j] = sO[t * 64 + c0 + j]; q += v[j] * v[j]; }
    q += __shfl_xor(q, 1); q += __shfl_xor(q, 2);
    const float rstd = rsqrtf(q * (1.f / 64.f) + EPSF);
    const bf16_t* gg = p.proj + (size_t)(row0 + t) * PLD + C_GG + hd * 64 + c0;
    const float* ng = p.hg_norm + l * 256 + hd * 64 + c0;
    bf16_t* dst = p.hbuf + (size_t)(row0 + t) * HLD + 768 + hd * 64 + c0;
    const bf16x8 gv0 = *(const bf16x8*)(gg), gv1 = *(const bf16x8*)(gg + 8);
    float ngv[16];
#pragma unroll
    for (int j = 0; j < 16; ++j) ngv[j] = ng[j];
    asm volatile("s_waitcnt vmcnt(0)" ::: "memory");
#pragma unroll
    for (int q2 = 0; q2 < 2; ++q2) {
      const bf16x8 gv = q2 ? gv1 : gv0;
      bf16x8 o;
#pragma unroll
      for (int j = 0; j < 8; ++j) o[j] = (short)f2bf(v[q2 * 8 + j] * rstd * ngv[q2 * 8 + j] * siluf_(bfs(gv[j])));
      *(bf16x8*)(dst + q2 * 8) = o;
    }
  }
}

DI void attn_item(const Params& p, int l, int item, char* smem) {
  bf16_t* sK = (bf16_t*)smem;
  bf16_t* sV = sK + 64 * 104;
  const int tid = tidx(), lane = tid & 63, w = tid >> 6;
  const int r = lane & 31, h = lane >> 5;
  int b, hd, tok0, nk, vld, krow_base;
  const bf16_t* Vt;
  bool lat;
  if (item < 512) {
    lat = true; b = item >> 7; hd = (item >> 4) & 7; const int qb = item & 15;
    tok0 = NCTX + b * 4096 + qb * 256; nk = 4608; vld = 4608;
    Vt = p.VtL + (size_t)((b * 8 + hd) * 64) * 4608; krow_base = NCTX + b * 4096;
  } else {
    const int it = item - 512;
    lat = false; b = it >> 3; hd = it & 7;
    tok0 = b * 256; nk = 256; vld = 256;
    Vt = p.VtC + (size_t)((b * 8 + hd) * 64) * 256; krow_base = b * 256;
  }
  const int q0 = tok0 + w * 64;
  bf16x8 bq[2][6];
#pragma unroll
  for (int g = 0; g < 2; ++g)
#pragma unroll
    for (int s = 0; s < 6; ++s)
      bq[g][s] = *(const bf16x8*)(p.Q + (size_t)(q0 + g * 32 + r) * 768 + hd * 96 + 16 * s + 8 * h);
  f32x16 o[2][2];
#pragma unroll
  for (int g = 0; g < 2; ++g) { o[g][0] = zero16(); o[g][1] = zero16(); }
  float m[2] = {-1e30f, -1e30f}, lsum[2] = {0.f, 0.f};
  u32x4 rk[2], rp, rv[2];
  const int nkeyA = tid >> 3, npartA = tid & 7;
  const int pkey = tid >> 2, ppart = tid & 3;
  auto gload = [&](int k0) {
    const bf16_t* pe_ptr;
    int pe_ld, krow;
    if (lat && k0 >= 4096) {
      krow = NTOK + b * 512 + (k0 - 4096);
      pe_ptr = p.kpec + ((size_t)(l * 4 + b) * 512 + (k0 - 4096)) * 32;
      pe_ld = 32;
    } else {
      krow = krow_base + k0;
      pe_ptr = p.proj + (size_t)krow * PLD + C_KPE;
      pe_ld = PLD;
    }
#pragma unroll
    for (int i = 0; i < 2; ++i) {
      rk[i] = *(const u32x4*)(p.Kn + ((size_t)(krow + nkeyA + i * 32) * 8 + hd) * 64 + npartA * 8);
      rv[i] = *(const u32x4*)(Vt + (size_t)(nkeyA + i * 32) * vld + k0 + npartA * 8);
    }
    rp = *(const u32x4*)(pe_ptr + (size_t)pkey * pe_ld + ppart * 8);
  };
  gload(0);
  for (int k0 = 0; k0 < nk; k0 += 64) {
    __syncthreads();
#pragma unroll
    for (int i = 0; i < 2; ++i) {
      *(u32x4*)(sK + (nkeyA + i * 32) * 104 + npartA * 8) = rk[i];
      *(u32x4*)(sV + (nkeyA + i * 32) * 72 + npartA * 8) = rv[i];
    }
    *(u32x4*)(sK + pkey * 104 + 64 + ppart * 8) = rp;
    __syncthreads();
    if (k0 + 64 < nk) gload(k0 + 64);
    f32x16 s[2][2];
#pragma unroll
    for (int kb = 0; kb < 2; ++kb) {
      s[0][kb] = zero16();
      s[1][kb] = zero16();
#pragma unroll
      for (int ks = 0; ks < 6; ++ks) {
        const bf16x8 a = *(const bf16x8*)(sK + (kb * 32 + r) * 104 + 16 * ks + 8 * h);
        s[0][kb] = mfma(a, bq[0][ks], s[0][kb]);
        s[1][kb] = mfma(a, bq[1][ks], s[1][kb]);
      }
    }
    __builtin_amdgcn_sched_barrier(0);
#pragma unroll
    for (int g = 0; g < 2; ++g) {
      float mx = m[g];
#pragma unroll
      for (int kb = 0; kb < 2; ++kb)
#pragma unroll
        for (int reg = 0; reg < 16; ++reg) mx = fmaxf(mx, s[g][kb][reg]);
      mx = fmaxf(mx, __shfl_xor(mx, 32));
      const bool changed = __any(mx > m[g]);
      float alpha = 1.f;
      if (changed) { alpha = __builtin_amdgcn_exp2f(m[g] - mx); m[g] = mx; }
      float ps = 0.f;
#pragma unroll
      for (int kb = 0; kb < 2; ++kb)
#pragma unroll
        for (int reg = 0; reg < 16; ++reg) {
          const float pv = __builtin_amdgcn_exp2f(s[g][kb][reg] - m[g]);
          s[g][kb][reg] = pv;
          ps += pv;
        }
      if (changed) {
        lsum[g] *= alpha;
#pragma unroll
        for (int i = 0; i < 2; ++i)
#pragma unroll
          for (int reg = 0; reg < 16; ++reg) o[g][i][reg] *= alpha;
      }
      lsum[g] += ps;
      bf16x8 pb[2][2];
#pragma unroll
      for (int kb = 0; kb < 2; ++kb)
#pragma unroll
        for (int s2 = 0; s2 < 2; ++s2) {
          u32x4 pw;
#pragma unroll
          for (int j = 0; j < 4; ++j) pw[j] = pk_bf16(s[g][kb][8 * s2 + 2 * j], s[g][kb][8 * s2 + 2 * j + 1]);
          pb[kb][s2] = __builtin_bit_cast(bf16x8, pw);
        }
      __builtin_amdgcn_sched_barrier(0);
#pragma unroll
      for (int kb = 0; kb < 2; ++kb) {
#pragma unroll
        for (int s2 = 0; s2 < 2; ++s2) {
#pragma unroll
          for (int i = 0; i < 2; ++i) {
            const bf16_t* vp = sV + (i * 32 + r) * 72 + kb * 32 + 16 * s2 + 4 * h;
            const bf16x4 lo = *(const bf16x4*)vp;
            const bf16x4 hi = *(const bf16x4*)(vp + 8);
            const bf16x8 av = __builtin_shufflevector(lo, hi, 0, 1, 2, 3, 4, 5, 6, 7);
            o[g][i] = mfma(av, pb[kb][s2], o[g][i]);
          }
        }
      }
      __builtin_amdgcn_sched_barrier(0);
    }
  }
#pragma unroll
  for (int g = 0; g < 2; ++g) {
    float lt = lsum[g];
    lt += __shfl_xor(lt, 32);
    const float inv = 1.f / lt;
    bf16_t* dst = p.hbuf + (size_t)(q0 + g * 32 + r) * HLD + hd * 64;
#pragma unroll
    for (int i = 0; i < 2; ++i)
#pragma unroll
      for (int gg = 0; gg < 4; ++gg) {
        u32x4 dummy;
        (void)dummy;
        bf16x4 pk;
#pragma unroll
        for (int q = 0; q < 4; ++q) pk[q] = (short)f2bf(o[g][i][4 * gg + q] * inv);
        *(bf16x4*)(dst + i * 32 + 8 * gg + 4 * h) = pk;
      }
  }
}

#define XB_TMO      128
#define XB_XCNT(j)  (256  + 64 * (j))
#define XB_XSUB(j)  (1280 + 64 * (j))
#define XB_XGEN(j)  (2304 + 64 * (j))
#define XB_TOP      3328
#define XB_TOPGEN   3392
#define XCD_BAR_WORDS 3456
#define XB_SPIN_CAP (1u << 22)
#define LAS __attribute__((address_space(3)))
DI unsigned xb_ld(unsigned* p) { return __hip_atomic_load(p, __ATOMIC_RELAXED, __HIP_MEMORY_SCOPE_AGENT); }
DI unsigned xb_add(unsigned* p, unsigned v) { return __hip_atomic_fetch_add(p, v, __ATOMIC_RELAXED, __HIP_MEMORY_SCOPE_AGENT); }
DI unsigned xb_xcc_id() { return (unsigned)__builtin_amdgcn_s_getreg((3 << 11) | 20) & 0xFu; }
#define XB_SPIN(cond, bar) do { unsigned _sp = 0; while (cond) { __builtin_amdgcn_s_sleep(1); \
    if ((++_sp & 255u) == 0u) { if (xb_ld(&(bar)[XB_TMO])) break; if (_sp > XB_SPIN_CAP) { atomicAdd(&(bar)[XB_TMO], 1u); break; } } } } while (0)
struct XcdBarrier { unsigned* bar; unsigned x; volatile LAS unsigned* st; };
DI XcdBarrier xcd_barrier_post(unsigned* bar, volatile LAS unsigned* st) {
  XcdBarrier b; b.bar = bar; b.x = 0u; b.st = st;
  if (threadIdx.x == 0) {
    const unsigned x = xb_xcc_id();
    st[2] = x;
    (void)xb_add(&bar[XB_XCNT(x)], 1u);
  }
  return b;
}
DI void xcd_barrier_complete(unsigned* bar, unsigned x, unsigned& nloc, unsigned& nx) {
  const unsigned G = gridDim.x * gridDim.y * gridDim.z;
  unsigned sum, cnt, mine, sp = 0u;
  for (;;) {
    sum = 0u; cnt = 0u; mine = 0u;
#pragma unroll
    for (unsigned j = 0; j < 16; ++j) { const unsigned c = xb_ld(&bar[XB_XCNT(j)]); sum += c; cnt += (c > 0u) ? 1u : 0u; mine = (j == x) ? c : mine; }
    if (sum == G) break;
    __builtin_amdgcn_s_sleep(1);
    if ((++sp & 255u) == 0u) { if (xb_ld(&bar[XB_TMO])) break; if (sp > XB_SPIN_CAP) { atomicAdd(&bar[XB_TMO], 1u); break; } }
  }
  nloc = mine > 0u ? mine : 1u; nx = cnt > 0u ? cnt : 1u;
}
DI void xcd_barrier(const XcdBarrier& b) {
  asm volatile("s_waitcnt vmcnt(0)" ::: "memory");
  __syncthreads();
  if (threadIdx.x == 0) {
    unsigned* bar = b.bar;
    __builtin_amdgcn_s_waitcnt(0);
    unsigned nloc = b.st[0], nx = b.st[1];
    const unsigned bx = __builtin_amdgcn_readfirstlane(b.st[2]);
    if (nloc == 0u) { xcd_barrier_complete(bar, bx, nloc, nx); b.st[0] = nloc; b.st[1] = nx; }
    const unsigned old = xb_add(&bar[XB_XSUB(bx)], 1u);
    const unsigned gen = old / nloc;
    if (old + 1u == (gen + 1u) * nloc) {
      __builtin_amdgcn_fence(__ATOMIC_RELEASE, "agent");
      asm volatile("s_waitcnt vmcnt(0)" ::: "memory");
      const unsigned og = xb_add(&bar[XB_TOP], 1u);
      const unsigned tg = og / nx;
      if (og + 1u == (tg + 1u) * nx) xb_add(&bar[XB_TOPGEN], 1u);
      else XB_SPIN(xb_ld(&bar[XB_TOPGEN]) == tg, bar);
      __builtin_amdgcn_fence(__ATOMIC_ACQUIRE, "agent");
      xb_add(&bar[XB_XGEN(bx)], 1u);
      asm volatile("s_waitcnt vmcnt(0)" ::: "memory");
    } else {
      XB_SPIN(xb_ld(&bar[XB_XGEN(bx)]) == gen, bar);
      __builtin_amdgcn_fence(__ATOMIC_ACQUIRE, "agent");
      asm volatile("s_waitcnt vmcnt(0)" ::: "memory");
    }
  }
  __syncthreads();
}

DI void run_phase(const Params& p, int ph, int l, char* smem, int bid, int nb) {
  asm volatile("" : "+s"(bid));
  switch (ph) {
#if !defined(ONLY) || ONLY==0
    case 0:
      phase0_misc(p, bid, nb, smem);
      convert_layer(p, 0, bid, nb, smem);
      break;
#endif
#if !defined(ONLY) || ONLY==1
    case 1: phase0_h(p, bid, nb); break;
#endif
#if !defined(ONLY) || ONLY==2
    case 2: {
      EpiIn epi{&p, l};
      if (nb == 512) {
        for (int k = 0, mt, nt; tile_map(bid, nb, k, 88, 22, mt, nt); ++k)
          gemm_tile<4, false, false>(p.hbuf, HLD, p.wb_in, HLD, 1024, mt * 256, nt * 128, epi, smem, false);
        const int slot2 = ((bid >> 3) + 14) & 63;
        for (int k = 0, mt, nt; tile_map((bid & 7) | (slot2 << 3), nb, k, 16, 22, mt, nt); ++k)
          gemm_tile<2, false, true>(p.hbuf, HLD, p.wb_in, HLD, 1024, 22528 + mt * 128, nt * 128, epi, smem, false);
      } else {
        gemm_run<false>(p.hbuf, HLD, p.wb_in, HLD, 1024, 192, 22, epi, smem, bid, nb);
      }
    } break;
#endif
#if !defined(ONLY) || ONLY==3
    case 3: {
      EpiQ eq{&p};
      EpiKV ekv{&p};
      const bool rev = bid >= (nb >> 1);
#pragma unroll 1
      for (int stg = 0; stg < 4; ++stg) {
        const int which = rev ? 3 - stg : stg;
        if (which == 0) {
      for (int k = 0, mt, nt; tile_map(bid, nb, k, 192, 6, mt, nt); ++k)
        gemm_tile<2, true, false>(p.proj + C_CQ, PLD, p.wb_uq, 256, 256, mt * 128, nt * 128, eq, smem, false);
        } else if (which == 1) {
      for (int k = 0, mt, nt; tile_map((bid + (nb >> 1)) % nb, nb, k, 208, 8, mt, nt); ++k) {
        const int m0 = mt * 128;
        if (m0 < NTOK) {
          gemm_tile<2, true, false>(p.proj + C_CKV, PLD, p.wb_ukv, 128, 128, m0, nt * 128, ekv, smem, false);
          if (nt == 0 && m0 < NCTX) {
            const float* sRS = (const float*)(smem + 2 * 128 * 72 * 2);
            const int t0 = tidx();
#pragma unroll 1
            for (int e0 = t0; e0 < 128 * 128; e0 += 256 * 8) {
              float vals[8];
#pragma unroll
              for (int u = 0; u < 8; ++u) {
                const int e = e0 + u * 256;
                const int rl = e >> 7, k = e & 127;
                vals[u] = bf2f(p.proj[(size_t)(m0 + rl) * PLD + C_CKV + k]) * sRS[rl] * p.kv_norm[l * 128 + k];
              }
              asm volatile("s_waitcnt vmcnt(0)" ::: "memory");
#pragma unroll
              for (int u = 0; u < 8; ++u) {
                const int e = e0 + u * 256;
                const int rl = e >> 7, k = e & 127;
                const int row = m0 + rl;
                const int b = row >> 8, tt = row & 255;
                p.out[O_CKV + ((size_t)(b * 4 + l) * 256 + tt) * 128 + k] = vals[u];
              }
            }
          }
        } else {
          const bf16_t* Ac = p.ckvc + (size_t)l * 2048 * 128 - (size_t)NTOK * 128;
          gemm_tile<2, true, false>(Ac, 128, p.wb_ukv, 128, 128, m0, nt * 128, ekv, smem, true);
        }
      }
        } else if (which == 2) {
      for (int t = bid; t < 1536; t += nb) mlstm_local(p, t >> 2, t & 3, smem);
        } else {
      for (int t = bid; t < 1536; t += nb) hgrn_local(p, l, t >> 2, t & 3, smem);
        }
      }
    } break;
#endif
#if !defined(ONLY) || ONLY==4
    case 4:
      for (int it = bid; it < 1152; it += nb) state_item(p, l, it);
      break;
#endif
#if !defined(ONLY) || ONLY==5
    case 5: {
      const bool rev = bid >= (nb >> 1);
#pragma unroll 1
      for (int stg = 0; stg < 2; ++stg) {
        const bool do_attn = (stg == 0) != rev;
        if (do_attn) {
          for (int it = bid; it < 512; it += nb) attn_item(p, l, it, smem);
          if (nb == 512) {
            if (bid >= 256) attn_item(p, l, 512 + (bid - 256), smem);
          } else {
            for (int it = bid; it < 256; it += nb) attn_item(p, l, 512 + it, smem);
          }
        } else {
          for (int it = bid; it < 3072; it += nb) {
            if (it < 1536) mlstm_out(p, l, it >> 2, it & 3, smem);
            else hgrn_out(p, l, (it - 1536) >> 2, (it - 1536) & 3, smem);
          }
        }
      }
    } break;
#endif
#if !defined(ONLY) || ONLY==6
    case 6: {
      EpiRes epi;
      if (l == 0) { epi.src0 = p.x_prompt; epi.src1 = p.x_sample - (size_t)NCTX * DM; epi.stats = nullptr; epi.gam = nullptr; epi.bet = nullptr; }
      else { epi.src0 = p.out; epi.src1 = p.out; epi.stats = p.S2; epi.gam = p.ln2_g + (l - 1) * DM; epi.bet = p.ln2_b + (l - 1) * DM; }
      epi.dst = p.X1;
      epi.gate = p.modv + (size_t)l * 5 * 6144 + 2048;
      if (nb == 512) {
        int mt, nt;
        if (tile_map(bid, nb, 0, 64, 8, mt, nt))
          gemm_tile<4, false, false>(p.hbuf, HLD, p.wb_out, HLD, 1024, mt * 256, nt * 128, epi, smem, false);
        if (tile_map(bid, nb, 0, 64, 8, mt, nt))
          gemm_tile<2, false, true>(p.hbuf, HLD, p.wb_out, HLD, 1024, 16384 + mt * 128, nt * 128, epi, smem, false);
      } else {
        gemm_run<false>(p.hbuf, HLD, p.wb_out, HLD, 1024, 192, 8, epi, smem, bid, nb);
      }
    } break;
#endif
#if !defined(ONLY) || ONLY==7
    case 7: ln_phase(p, l, 1, bid, nb); break;
#endif
#if !defined(ONLY) || ONLY==8
    case 8: {
      EpiFF epi{p.proj};
      for (int k = 0, mt, nt; tile_map(bid, nb, k, 96, 44, mt, nt); ++k)
        gemm_tile<4, false, false>(p.hbuf, HLD, p.wb_ffi, HLD, 1024, mt * 256, nt * 128, epi, smem, false);
    } break;
#endif
#if !defined(ONLY) || ONLY==9
    case 9: {
      EpiRes epi;
      epi.src0 = p.X1; epi.src1 = p.X1; epi.dst = p.out;
      epi.stats = p.S1; epi.gam = p.ln1_g + l * DM; epi.bet = p.ln1_b + l * DM;
      epi.gate = p.modv + (size_t)l * 5 * 6144 + 5120;
      if (nb == 512) {
        int mt, nt;
        if (tile_map(bid, nb, 0, 64, 8, mt, nt))
          gemm_tile<4, false, false>(p.proj, PLD, p.wb_ffo, PLD, FFD, mt * 256, nt * 128, epi, smem, false);
        if (tile_map(bid, nb, 0, 64, 8, mt, nt))
          gemm_tile<2, false, true>(p.proj, PLD, p.wb_ffo, PLD, FFD, 16384 + mt * 128, nt * 128, epi, smem, false);
      } else {
        gemm_run<false>(p.proj, PLD, p.wb_ffo, PLD, FFD, 192, 8, epi, smem, bid, nb);
      }
    } break;
#endif
#if !defined(ONLY) || ONLY==10
    case 10:
      ln_phase(p, l, 2, bid, nb);
      if (l < 3) convert_layer(p, l + 1, bid, nb, smem);
      break;
#endif
  }
}

#if SINGLE
constexpr int DYN_LDS = 73728 + 64;
__global__ void __launch_bounds__(256, 2) mega_kernel(Params p) {
  extern __shared__ __attribute__((aligned(16))) char smem[];
  unsigned* xb_words = (unsigned*)(smem + 73728);
  cg::grid_group grid = cg::this_grid();
  const int bid = blockIdx.x, nb = gridDim.x;
  if (threadIdx.x < 4) xb_words[threadIdx.x] = 0u;
  __syncthreads();
  XcdBarrier xb = xcd_barrier_post(p.bar, (volatile LAS unsigned*)xb_words);
  if (gridDim.y == 7777u) grid.sync();
  run_phase(p, 0, 0, smem, bid, nb);
  xcd_barrier(xb);
  run_phase(p, 1, 0, smem, bid, nb);
  xcd_barrier(xb);
#pragma unroll 1
  for (int l = 0; l < 4; ++l) {
#pragma unroll 1
    for (int ph = 2; ph <= 10; ++ph) {
      run_phase(p, ph, l, smem, bid, nb);
      if (!(l == 3 && ph == 10)) xcd_barrier(xb);
    }
  }
}
#else
__global__ void __launch_bounds__(256, 2) phase_kernel(Params p, int ph, int l) {
  __shared__ __attribute__((aligned(16))) char smem[65536];
  run_phase(p, ph, l, smem, blockIdx.x, gridDim.x);
}
#endif

extern "C" void kernel_launch(void* const* d_in, const int* in_sizes, int n_in, void* d_out, int out_size, void* d_ws,
                              size_t ws_size, hipStream_t stream) {
  Params p{};
  const float** f = (const float**)&p;
  for (int i = 0; i < 28; ++i) f[i] = (const float*)d_in[i];
  p.out = (float*)d_out;
  char* ws = (char*)d_ws;
  size_t off = 0;
  auto take = [&](size_t bytes) { char* r = ws + off; off += (bytes + 255) & ~(size_t)255; return r; };
  p.wb_in = (bf16_t*)take((size_t)2816 * HLD * 2);
  p.wb_uq = (bf16_t*)take((size_t)768 * 256 * 2);
  p.wb_ukv = (bf16_t*)take((size_t)1024 * 128 * 2);
  p.wb_out = (bf16_t*)take((size_t)1024 * HLD * 2);
  p.wb_ffi = (bf16_t*)take((size_t)5632 * HLD * 2);
  p.wb_ffo = (bf16_t*)take((size_t)1024 * PLD * 2);
  p.modv = (float*)take((size_t)4 * 5 * 6144 * 4);
  p.lbs = (float*)take(4 * 256 * 4);
  p.rope = (float*)take(1024 * 4);
  p.ckvc = (bf16_t*)take((size_t)4 * 4 * 512 * 128 * 2);
  p.kpec = (bf16_t*)take((size_t)4 * 4 * 512 * 32 * 2);
  p.X1 = (float*)take((size_t)NTOK * DM * 4);
  p.hbuf = (bf16_t*)take((size_t)NTOK * HLD * 2);
  p.proj = (bf16_t*)take((size_t)NTOK * PLD * 2);
  p.gates = (float*)take((size_t)NTOK * 16 * 4);
  p.Kn = (bf16_t*)take((size_t)NKV * 512 * 2);
  p.VtC = (bf16_t*)take((size_t)32 * 8 * 64 * 256 * 2);
  p.VtL = (bf16_t*)take((size_t)4 * 8 * 64 * 4608 * 2);
  p.Mg = (float*)take(8 * NTC * 4);
  p.Mumax = (float*)take(8 * NTC * 4);
  p.Mm = (float*)take(8 * NTC * 4);
  p.Mn = (float*)take((size_t)8 * NTC * 64 * 4);
  p.Hd = (float*)take((size_t)8 * NTC * 64 * 4);
  p.bar = (unsigned*)take(XCD_BAR_WORDS * 4);
  p.S1 = (float2*)take((size_t)NTOK * 8);
  p.S2 = (float2*)take((size_t)NTOK * 8);
  p.MU = (bf16_t*)p.X1;
  p.HU = p.MU + (size_t)8 * NTC * 4096;
  p.Q = p.HU + (size_t)8 * NTC * 4096;
  if (off > ws_size) {
    fprintf(stderr, "workspace too small: need %zu have %zu\n", off, ws_size);
    return;
  }
#if SINGLE
  static int grid_blocks = 0;
  if (!grid_blocks) {
    int dev = 0, cus = 0, per_cu = 0;
    hipGetDevice(&dev);
    hipDeviceGetAttribute(&cus, hipDeviceAttributeMultiprocessorCount, dev);
    hipFuncSetAttribute((const void*)mega_kernel, hipFuncAttributeMaxDynamicSharedMemorySize, DYN_LDS);
    hipOccupancyMaxActiveBlocksPerMultiprocessor(&per_cu, mega_kernel, 256, DYN_LDS);
    if (per_cu > 2) per_cu = 2;
    grid_blocks = cus * per_cu;
  }
  hipMemsetAsync(p.bar, 0, XCD_BAR_WORDS * 4, stream);
  void* args[] = {&p};
  hipError_t e = hipLaunchCooperativeKernel((void*)mega_kernel, dim3(grid_blocks), dim3(256), args, DYN_LDS, stream);
  if (e != hipSuccess) fprintf(stderr, "cooperative launch failed: %s (grid %d)\n", hipGetErrorString(e), grid_blocks);
#else
  phase_kernel<<<512, 256, 0, stream>>>(p, 0, 0);
  phase_kernel<<<512, 256, 0, stream>>>(p, 1, 0);
  for (int l = 0; l < 4; ++l)
    for (int ph = 2; ph <= 10; ++ph) phase_kernel<<<512, 256, 0, stream>>>(p, ph, l);
#endif
}
```

```cpp
#include <hip/hip_runtime.h>
#include <hip/hip_cooperative_groups.h>
#include <cstdio>
namespace cg = cooperative_groups;

#ifndef SINGLE
#define SINGLE 1
#endif

#define DI __device__ __forceinline__
typedef unsigned short bf16_t;
using bf16x8 = __attribute__((ext_vector_type(8))) short;
using bf16x4 = __attribute__((ext_vector_type(4))) short;
using f32x16 = __attribute__((ext_vector_type(16))) float;
using u32x4 = __attribute__((ext_vector_type(4))) unsigned;

constexpr int NTOK = 24576, NCTX = 8192, DM = 1024;
constexpr int PLD = 2880, IN_COLS = 2736, FFD = 2816;
constexpr int HLD = 1088;
constexpr int NTC = 384;
constexpr int NKV = NTOK + 2048;
constexpr float EPSF = 1e-6f;
constexpr float ALPHA = 1.6817928305074292f;
constexpr float QSCALE = 0.10206207261596577f * 1.4426950408889634f;
constexpr int C_CQ = 0, C_CKV = 256, C_KPE = 384, C_MQ = 416, C_MK = 672, C_MV = 928, C_MO = 1184, C_GATE = 1440,
              C_GQ = 1456, C_GFF = 1712, C_GFB = 1968, C_GI = 2224, C_GG = 2480;
constexpr size_t O_YP = 0, O_YS = 8388608, O_CKV = 25165824, O_KPE = 29360128, O_C = 30408704, O_N = 34603008,
                 O_M = 34668544, O_S = 34669568;

struct Params {
  const float *x_prompt, *x_sample, *cache_ckv, *cache_kpe, *st_C, *st_n, *st_m, *st_S, *c, *c_ctx, *w_mod, *b_mod,
      *w_in, *b_in, *q_norm, *w_uq, *kv_norm, *w_ukv, *ml_norm, *lb_logits, *hg_norm, *w_out, *ln1_g, *ln1_b, *w_ffi,
      *w_ffo, *ln2_g, *ln2_b;
  float* out;
  bf16_t *wb_in, *wb_uq, *wb_ukv, *wb_out, *wb_ffi, *wb_ffo;
  float *modv, *lbs, *rope;
  bf16_t *ckvc, *kpec;
  float* X1;
  bf16_t *hbuf, *proj;
  float* gates;
  bf16_t *Q, *Kn, *VtC, *VtL, *MU, *HU;
  float *Mg, *Mumax, *Mn, *Mm, *Hd;
  unsigned* bar;
  float2 *S1, *S2;
};

typedef __bf16 hbf2 __attribute__((ext_vector_type(2)));
typedef float f32x2 __attribute__((ext_vector_type(2)));
DI bf16_t f2bf(float x) { return __builtin_bit_cast(unsigned short, (__bf16)x); }
DI unsigned pk_bf16(float a, float b) {
  f32x2 v = {a, b};
  return __builtin_bit_cast(unsigned, __builtin_convertvector(v, hbf2));
}
DI float bf2f(bf16_t v) { return __uint_as_float(((unsigned)v) << 16); }
DI float bfs(short v) { return __uint_as_float(((unsigned)(unsigned short)v) << 16); }
DI int tidx() { int t = threadIdx.x; asm volatile("" : "+v"(t)); return t; }
DI int crow(int reg, int h) { return (reg & 3) + 8 * (reg >> 2) + 4 * h; }
DI float sigmoidf_(float x) { return __builtin_amdgcn_rcpf(1.f + __expf(-x)); }
DI float siluf_(float x) { return x * __builtin_amdgcn_rcpf(1.f + __expf(-x)); }
DI f32x16 mfma(bf16x8 a, bf16x8 b, f32x16 c) { return __builtin_amdgcn_mfma_f32_32x32x16_bf16(a, b, c, 0, 0, 0); }
DI f32x16 zero16() {
  f32x16 z = {0.f, 0.f, 0.f, 0.f, 0.f, 0.f, 0.f, 0.f, 0.f, 0.f, 0.f, 0.f, 0.f, 0.f, 0.f, 0.f};
  return z;
}
DI void wave_mma1(f32x16& acc, const bf16_t* A, int lda, const bf16_t* Bt, int ldb, int K, int lane) {
  const int r = lane & 31, h = lane >> 5;
  for (int k0 = 0; k0 < K; k0 += 16) {
    bf16x8 a = *(const bf16x8*)(A + r * lda + k0 + 8 * h);
    bf16x8 b = *(const bf16x8*)(Bt + r * ldb + k0 + 8 * h);
    acc = mfma(a, b, acc);
  }
}
DI int cvec_of(int row) { return row < NCTX ? 0 : 1 + ((row - NCTX) >> 12); }

DI bool tile_map(int bid, int nb, int k, int Mt, int Nt, int& mt, int& nt) {
  const int xcd = bid & 7, slot = bid >> 3, spx = nb >> 3;
  const int mpx = Mt >> 3;
  const int u = slot + k * spx;
  if (u >= mpx * Nt) return false;
  const int pw = 8 * Nt;
  const int pn = u / pw, rem = u - pn * pw;
  const int hgt = min(8, mpx - 8 * pn);
  nt = rem / hgt;
  mt = xcd * mpx + 8 * pn + (rem - nt * hgt);
  return true;
}

template <int MI, bool RS, bool TWO, class Epi>
DI void gemm_tile(const bf16_t* __restrict__ A, int lda, const bf16_t* __restrict__ Bt, int ldb, int K, int m0, int n0,
                  const Epi& epi, char* smem, bool rs_one) {
  constexpr int BM = 64 * MI;
  constexpr int NA = BM / 32;
  bf16_t* sA = (bf16_t*)smem;
  bf16_t* sB = sA + BM * 72;
  float* sRS = (float*)(sB + 128 * 72);
  const int tid = tidx(), lane = tid & 63, w = tid >> 6, wm = w >> 1, wn = w & 1;
  const int r = lane & 31, h = lane >> 5;
  f32x16 acc[MI][2];
#pragma unroll
  for (int i = 0; i < MI; ++i)
#pragma unroll
    for (int j = 0; j < 2; ++j) acc[i][j] = zero16();
  u32x4 ra0[NA], rb0[4], ra1[TWO ? NA : 1], rb1[TWO ? 4 : 1];
  const int lrow = tid >> 3, lkc = (tid & 7) * 8;
  const bf16_t* Ap = A + (size_t)(m0 + lrow) * lda + lkc;
  const bf16_t* Bp = Bt + (size_t)(n0 + lrow) * ldb + lkc;
  float ss = 0.f;
  auto gl = [&](u32x4* ra, u32x4* rb, int k0) {
#pragma unroll
    for (int i = 0; i < NA; ++i) ra[i] = *(const u32x4*)(Ap + (size_t)i * 32 * lda + k0);
#pragma unroll
    for (int i = 0; i < 4; ++i) rb[i] = *(const u32x4*)(Bp + (size_t)i * 32 * ldb + k0);
  };
  auto body = [&](u32x4* ra, u32x4* rb, int knext) {
    __syncthreads();
#pragma unroll
    for (int i = 0; i < NA; ++i) *(u32x4*)(sA + (lrow + i * 32) * 72 + lkc) = ra[i];
#pragma unroll
    for (int i = 0; i < 4; ++i) *(u32x4*)(sB + (lrow + i * 32) * 72 + lkc) = rb[i];
    __syncthreads();
    if (knext < K) gl(ra, rb, knext);
    if (RS) {
      constexpr int TPR = 256 / BM;
      constexpr int EPT = 64 / TPR;
      const bf16_t* rp = sA + (tid / TPR) * 72 + (tid % TPR) * EPT;
#pragma unroll
      for (int q = 0; q < EPT / 8; ++q) {
        bf16x8 v = *(const bf16x8*)(rp + q * 8);
#pragma unroll
        for (int j = 0; j < 8; ++j) {
          float f = bfs(v[j]);
          ss += f * f;
        }
      }
    }
    bf16x8 fa[2][MI], fb[2][2];
#pragma unroll
    for (int i = 0; i < MI; ++i) fa[0][i] = *(const bf16x8*)(sA + (wm * 32 * MI + i * 32 + r) * 72 + 8 * h);
#pragma unroll
    for (int j = 0; j < 2; ++j) fb[0][j] = *(const bf16x8*)(sB + (wn * 64 + j * 32 + r) * 72 + 8 * h);
#pragma unroll
    for (int s4 = 0; s4 < 4; ++s4) {
      const int cur = s4 & 1, nxt = cur ^ 1;
      if (s4 < 3) {
#pragma unroll
        for (int i = 0; i < MI; ++i)
          fa[nxt][i] = *(const bf16x8*)(sA + (wm * 32 * MI + i * 32 + r) * 72 + (s4 + 1) * 16 + 8 * h);
#pragma unroll
        for (int j = 0; j < 2; ++j)
          fb[nxt][j] = *(const bf16x8*)(sB + (wn * 64 + j * 32 + r) * 72 + (s4 + 1) * 16 + 8 * h);
      }
      __builtin_amdgcn_sched_barrier(0);
#pragma unroll
      for (int i = 0; i < MI; ++i)
#pragma unroll
        for (int j = 0; j < 2; ++j) acc[i][j] = mfma(fa[cur][i], fb[cur][j], acc[i][j]);
      __builtin_amdgcn_sched_barrier(0);
    }
  };
  if (TWO) {
    gl(ra0, rb0, 0);
    gl(ra1, rb1, 64);
    for (int k0 = 0; k0 < K; k0 += 128) {
      body(ra0, rb0, k0 + 128);
      body(ra1, rb1, k0 + 192);
    }
  } else {
    gl(ra0, rb0, 0);
    for (int k0 = 0; k0 < K; k0 += 64) body(ra0, rb0, k0 + 64);
  }
  if (RS) {
    constexpr int TPR = 256 / BM;
    if (TPR == 2) ss += __shfl_xor(ss, 1);
    if ((tid % TPR) == 0) sRS[tid / TPR] = rs_one ? 1.f : rsqrtf(ss / (float)K + EPSF);
    __syncthreads();
  }
  __syncthreads();
#pragma unroll
  for (int ih = 0; ih < MI / 2; ++ih)
    epi(reinterpret_cast<f32x16(&)[2][2]>(acc[2 * ih]), m0 + wm * 32 * MI + ih * 64, n0 + wn * 64, lane,
        sRS + wm * 32 * MI + ih * 64, (bf16_t*)smem + w * (64 * 72));
}


template <int NJ>
DI void stage_store(const f32x16 (&v)[2][2], bf16_t* st, bf16_t* dst, size_t ld, int lane) {
  const int r = lane & 31, h = lane >> 5;
#pragma unroll
  for (int i = 0; i < 2; ++i)
#pragma unroll
    for (int j = 0; j < NJ; ++j)
#pragma unroll
      for (int reg = 0; reg < 16; ++reg) st[(i * 32 + crow(reg, h)) * 72 + j * 32 + r] = f2bf(v[i][j][reg]);
  asm volatile("s_waitcnt lgkmcnt(0)" ::: "memory");
  constexpr int CPR = 4 * NJ;
#pragma unroll
  for (int q = 0; q < CPR; ++q) {
    const int c = lane + 64 * q;
    const int row = c / CPR, part = c % CPR;
    *(u32x4*)(dst + (size_t)row * ld + part * 8) = *(const u32x4*)(st + row * 72 + part * 8);
  }
  asm volatile("s_waitcnt lgkmcnt(0)" ::: "memory");
}

DI void rope_apply(float& v, const float* rope, int row, int r) {
  const int t = (row - NCTX) & 4095;
  const int pos = (r < 16) ? (t >> 6) : (t & 63);
  const float cs = rope[pos * 8 + (r & 7)], sn = rope[512 + pos * 8 + (r & 7)];
  const float pv = __shfl_xor(v, 8);
  v = v * cs + ((r & 8) ? pv : -pv) * sn;
}

struct EpiIn {
  const Params* p;
  int l;
  DI void operator()(f32x16 (&acc)[2][2], int mrow0, int ncol0, int lane, const float*, bf16_t* st) const {
    const int r = lane & 31, h = lane >> 5;
    const bool latent = mrow0 >= NCTX;
    if (ncol0 != 384 && ncol0 != 1408 && ncol0 + 64 <= IN_COLS) {
#pragma unroll
      for (int j = 0; j < 2; ++j) {
        const float bias = p->b_in[l * IN_COLS + ncol0 + j * 32 + r];
#pragma unroll
        for (int i = 0; i < 2; ++i)
#pragma unroll
          for (int reg = 0; reg < 16; ++reg) acc[i][j][reg] += bias;
      }
      stage_store<2>(acc, st, p->proj + (size_t)mrow0 * PLD + ncol0, PLD, lane);
      return;
    }
    float* sf = (float*)st;
#pragma unroll 1
    for (int j = 0; j < 2; ++j) {
      const int cb = ncol0 + j * 32;
      if (cb >= IN_COLS) continue;
      const int col = cb + r;
      const float bias = (col < IN_COLS) ? p->b_in[l * IN_COLS + col] : 0.f;
#pragma unroll
      for (int i = 0; i < 2; ++i)
#pragma unroll
        for (int reg = 0; reg < 16; ++reg) {
          float v = (j == 0 ? acc[i][0][reg] : acc[i][1][reg]) + bias;
          if (cb == C_KPE && latent) rope_apply(v, p->rope, mrow0 + i * 32 + crow(reg, h), r);
          sf[(i * 32 + crow(reg, h)) * 36 + r] = v;
        }
      asm volatile("s_waitcnt lgkmcnt(0)" ::: "memory");
      {
        const int row = mrow0 + lane;
        bf16_t* pr = p->proj + (size_t)row * PLD + cb;
        float* ok = p->out + O_KPE + ((size_t)((row >> 8) * 4 + l) * 256 + (row & 255)) * 32;
        float* gp = p->gates + (size_t)row * 16;
        const int ncol = (IN_COLS - cb >= 32) ? 32 : 16;
#pragma unroll 1
        for (int q = 0; q < 4; ++q) {
          const float4 a = *(const float4*)(sf + lane * 36 + q * 8);
          const float4 b = *(const float4*)(sf + lane * 36 + q * 8 + 4);
          u32x4 o;
          o[0] = pk_bf16(a.x, a.y); o[1] = pk_bf16(a.z, a.w); o[2] = pk_bf16(b.x, b.y); o[3] = pk_bf16(b.z, b.w);
          if (cb == C_KPE) {
            if (!latent) { *(float4*)(ok + q * 8) = a; *(float4*)(ok + q * 8 + 4) = b; }
            *(u32x4*)(pr + q * 8) = o;
          } else if (cb == C_GATE) {
            if (q < 2) { *(float4*)(gp + q * 8) = a; *(float4*)(gp + q * 8 + 4) = b; }
            else *(u32x4*)(pr + q * 8) = o;
          } else if (q * 8 < ncol) {
            *(u32x4*)(pr + q * 8) = o;
          }
        }
      }
      asm volatile("s_waitcnt lgkmcnt(0)" ::: "memory");
    }
  }
};

struct EpiQ {
  const Params* p;
  DI void operator()(f32x16 (&acc)[2][2], int mrow0, int ncol0, int lane, const float* rsw, bf16_t* st) const {
    const int r = lane & 31, h = lane >> 5;
    const bool latent = mrow0 >= NCTX;
#pragma unroll
    for (int j = 0; j < 2; ++j) {
      const int cb = ncol0 + j * 32;
      const bool pe = (cb % 96) == 64;
#pragma unroll
      for (int i = 0; i < 2; ++i) {
#pragma unroll
        for (int reg = 0; reg < 16; ++reg) {
          const int rl = i * 32 + crow(reg, h);
          float v = acc[i][j][reg] * rsw[rl] * QSCALE;
          if (pe && latent) rope_apply(v, p->rope, mrow0 + rl, r);
          acc[i][j][reg] = v;
        }
      }
    }
    stage_store<2>(acc, st, p->Q + (size_t)mrow0 * 768 + ncol0, 768, lane);
  }
};

struct EpiKV {
  const Params* p;
  DI void operator()(f32x16 (&acc)[2][2], int mrow0, int ncol0, int lane, const float* rsw, bf16_t* st) const {
    const int r = lane & 31, h = lane >> 5;
    if ((ncol0 & 127) == 0) {
#pragma unroll
      for (int i = 0; i < 2; ++i)
#pragma unroll
        for (int j = 0; j < 2; ++j)
#pragma unroll
          for (int reg = 0; reg < 16; ++reg) acc[i][j][reg] *= rsw[i * 32 + crow(reg, h)];
      stage_store<2>(acc, st, p->Kn + ((size_t)mrow0 * 8 + (ncol0 >> 7)) * 64, 512, lane);
      return;
    }
#pragma unroll
    for (int j = 0; j < 2; ++j) {
      const int cb = ncol0 + j * 32;
      const int hd = cb >> 7, within = cb & 127;
#pragma unroll
      for (int i = 0; i < 2; ++i) {
        if (within < 64) {
#pragma unroll
          for (int reg = 0; reg < 16; ++reg) {
            const int rl = i * 32 + crow(reg, h);
            const int row = mrow0 + rl;
            p->Kn[((size_t)row * 8 + hd) * 64 + within + r] = f2bf(acc[i][j][reg] * rsw[rl]);
          }
        } else {
          const int dv = within - 64 + r;
#pragma unroll
          for (int g = 0; g < 4; ++g) {
            const int rl = i * 32 + 8 * g + 4 * h;
            const int row = mrow0 + rl;
            bf16x4 pk;
#pragma unroll
            for (int q = 0; q < 4; ++q) pk[q] = (short)f2bf(acc[i][j][4 * g + q] * rsw[rl + q]);
            bf16_t* dst;
            if (row < NCTX) {
              const int b = row >> 8, key = row & 255;
              dst = p->VtC + ((size_t)((b * 8 + hd) * 64 + dv)) * 256 + key;
            } else if (row < NTOK) {
              const int rr = row - NCTX;
              const int b = rr >> 12, key = rr & 4095;
              dst = p->VtL + ((size_t)((b * 8 + hd) * 64 + dv)) * 4608 + key;
            } else {
              const int rr = row - NTOK;
              const int b = rr >> 9, key = 4096 + (rr & 511);
              dst = p->VtL + ((size_t)((b * 8 + hd) * 64 + dv)) * 4608 + key;
            }
            *(bf16x4*)dst = pk;
          }
        }
      }
    }
  }
};

struct EpiRes {
  const float* src0;
  const float* src1;
  float* dst;
  const float* gate;
  const float2* stats;
  const float* gam;
  const float* bet;
  DI void operator()(f32x16 (&acc)[2][2], int mrow0, int ncol0, int lane, const float*, bf16_t* st) const {
    const int r = lane & 31, h = lane >> 5;
    const float* src = mrow0 < NCTX ? src0 : src1;
    const float* gp = gate + cvec_of(mrow0) * 6144;
    float* sf = (float*)st;
#pragma unroll
    for (int j = 0; j < 2; ++j) {
      const int cb = ncol0 + j * 32;
      const float g = gp[cb + r];
#pragma unroll
      for (int i = 0; i < 2; ++i)
#pragma unroll
        for (int reg = 0; reg < 16; ++reg) sf[(i * 32 + crow(reg, h)) * 36 + r] = g * acc[i][j][reg];
      asm volatile("s_waitcnt lgkmcnt(0)" ::: "memory");
      const int part = lane & 7;
      const int col = cb + part * 4;
      float4 ga = make_float4(1.f, 1.f, 1.f, 1.f), be = make_float4(0.f, 0.f, 0.f, 0.f);
      if (stats) { ga = *(const float4*)(gam + col); be = *(const float4*)(bet + col); }
      float4 xs[8];
      float2 ms[8];
#pragma unroll
      for (int q = 0; q < 8; ++q) {
        const int row = mrow0 + (lane >> 3) + 8 * q;
        xs[q] = *(const float4*)(src + (size_t)row * DM + col);
        ms[q] = stats ? stats[row] : make_float2(0.f, 1.f);
      }
      asm volatile("s_waitcnt vmcnt(0)" ::: "memory");
#pragma unroll
      for (int q = 0; q < 8; ++q) {
        const int rl = (lane >> 3) + 8 * q;
        const float4 a = *(const float4*)(sf + rl * 36 + part * 4);
        float4 x = xs[q];
        if (stats) {
          x.x = (x.x - ms[q].x) * ms[q].y * ga.x + be.x; x.y = (x.y - ms[q].x) * ms[q].y * ga.y + be.y;
          x.z = (x.z - ms[q].x) * ms[q].y * ga.z + be.z; x.w = (x.w - ms[q].x) * ms[q].y * ga.w + be.w;
        }
        float4 y;
        y.x = ALPHA * x.x + a.x; y.y = ALPHA * x.y + a.y; y.z = ALPHA * x.z + a.z; y.w = ALPHA * x.w + a.w;
        *(float4*)(dst + (size_t)(mrow0 + rl) * DM + col) = y;
      }
      asm volatile("s_waitcnt lgkmcnt(0)" ::: "memory");
    }
  }
};

struct EpiFF {
  bf16_t* act;
  DI void operator()(f32x16 (&acc)[2][2], int mrow0, int ncol0, int lane, const float*, bf16_t* st) const {
    const int col0 = (ncol0 >> 6) * 32;
#pragma unroll
    for (int i = 0; i < 2; ++i)
#pragma unroll
      for (int reg = 0; reg < 16; ++reg) acc[i][0][reg] = siluf_(acc[i][0][reg]) * acc[i][1][reg];
    stage_store<1>(acc, st, act + (size_t)mrow0 * PLD + col0, PLD, lane);
  }
};


template <bool PRE, class Epi>
DI void gemm_run(const bf16_t* __restrict__ A, int lda, const bf16_t* __restrict__ Bt, int ldb, int K, int Mt, int Nt,
                 const Epi& epi, char* smem, int bid, int nb) {
  constexpr int BUF = 2 * 128 * 72;
  bf16_t* sbase = (bf16_t*)smem;
  const int tid = tidx(), lane = tid & 63, w = tid >> 6, wm = w >> 1, wn = w & 1;
  const int r = lane & 31, h = lane >> 5;
  const int lrow = tid >> 3, lkc = (tid & 7) * 8;
  int kt = 0, mt, nt;
  if (!tile_map(bid, nb, kt, Mt, Nt, mt, nt)) return;
  const bf16_t* Ap = A + (size_t)(mt * 128 + lrow) * lda + lkc;
  const bf16_t* Bp = Bt + (size_t)(nt * 128 + lrow) * ldb + lkc;
  u32x4 ra0[4], rb0[4], ra1[4], rb1[4];
  auto gl = [&](u32x4* ra, u32x4* rb, int k0) {
#pragma unroll
    for (int i = 0; i < 4; ++i) ra[i] = *(const u32x4*)(Ap + (size_t)i * 32 * lda + k0);
#pragma unroll
    for (int i = 0; i < 4; ++i) rb[i] = *(const u32x4*)(Bp + (size_t)i * 32 * ldb + k0);
  };
  auto lw = [&](const u32x4* ra, const u32x4* rb, int buf) {
    bf16_t* sA = sbase + buf * BUF;
    bf16_t* sB = sA + 128 * 72;
#pragma unroll
    for (int i = 0; i < 4; ++i) *(u32x4*)(sA + (lrow + i * 32) * 72 + lkc) = ra[i];
#pragma unroll
    for (int i = 0; i < 4; ++i) *(u32x4*)(sB + (lrow + i * 32) * 72 + lkc) = rb[i];
  };
  f32x16 acc[2][2];
  auto compute = [&](int buf) {
    const bf16_t* sA = sbase + buf * BUF + (wm * 64 + r) * 72 + 8 * h;
    const bf16_t* sB = sbase + buf * BUF + 128 * 72 + (wn * 64 + r) * 72 + 8 * h;
    bf16x8 fa[2][2], fb[2][2];
#pragma unroll
    for (int i = 0; i < 2; ++i) fa[0][i] = *(const bf16x8*)(sA + i * 32 * 72);
#pragma unroll
    for (int j = 0; j < 2; ++j) fb[0][j] = *(const bf16x8*)(sB + j * 32 * 72);
#pragma unroll
    for (int s4 = 0; s4 < 4; ++s4) {
      const int cur = s4 & 1, nxt = cur ^ 1;
      if (s4 < 3) {
#pragma unroll
        for (int i = 0; i < 2; ++i) fa[nxt][i] = *(const bf16x8*)(sA + i * 32 * 72 + (s4 + 1) * 16);
#pragma unroll
        for (int j = 0; j < 2; ++j) fb[nxt][j] = *(const bf16x8*)(sB + j * 32 * 72 + (s4 + 1) * 16);
      }
      __builtin_amdgcn_sched_barrier(0);
#pragma unroll
      for (int i = 0; i < 2; ++i)
#pragma unroll
        for (int j = 0; j < 2; ++j) acc[i][j] = mfma(fa[cur][i], fb[cur][j], acc[i][j]);
      __builtin_amdgcn_sched_barrier(0);
    }
  };
  gl(ra0, rb0, 0);
  gl(ra1, rb1, 64);
  for (;;) {
#pragma unroll
    for (int i = 0; i < 2; ++i)
#pragma unroll
      for (int j = 0; j < 2; ++j) acc[i][j] = zero16();
    __syncthreads();
    lw(ra0, rb0, 0);
    if (128 < K) gl(ra0, rb0, 128);
    __syncthreads();
    for (int k0 = 0; k0 < K; k0 += 128) {
      lw(ra1, rb1, 1);
      if (k0 + 192 < K) gl(ra1, rb1, k0 + 192);
      compute(0);
      __syncthreads();
      if (k0 + 128 < K) {
        lw(ra0, rb0, 0);
        if (k0 + 256 < K) gl(ra0, rb0, k0 + 256);
      }
      compute(1);
      __syncthreads();
    }
    const int m0 = mt * 128, n0 = nt * 128;
    const bool more = tile_map(bid, nb, ++kt, Mt, Nt, mt, nt);
    if (PRE && more) {
      Ap = A + (size_t)(mt * 128 + lrow) * lda + lkc;
      Bp = Bt + (size_t)(nt * 128 + lrow) * ldb + lkc;
      gl(ra0, rb0, 0);
      gl(ra1, rb1, 64);
    }
    epi(acc, m0 + wm * 64, n0 + wn * 64, lane, (const float*)nullptr, (bf16_t*)smem + w * (64 * 72));
    if (!more) break;
    if (!PRE) {
      Ap = A + (size_t)(mt * 128 + lrow) * lda + lkc;
      Bp = Bt + (size_t)(nt * 128 + lrow) * ldb + lkc;
      gl(ra0, rb0, 0);
      gl(ra1, rb1, 64);
    }
  }
}

DI void convert_tile(const float* __restrict__ W, bf16_t* __restrict__ Wt, int ldw, int K, int N, int mode,
                     const float* __restrict__ g, int kt, int nt, char* smem) {
  float* s = (float*)smem;
  const int tid = tidx(), tx = tid & 63, ty = tid >> 6;
  const int k0 = kt * 64, n0 = nt * 64;
  int src;
  if (mode == 1) src = (tx < 32) ? (nt * 32 + tx) : (FFD + nt * 32 + tx - 32);
  else src = n0 + tx;
  __syncthreads();
#pragma unroll
  for (int i = 0; i < 16; ++i) {
    const int k = ty + 4 * i;
    float v = (src < N) ? W[(size_t)(k0 + k) * N + src] : 0.f;
    if (g) v *= g[k0 + k];
    s[k * 65 + tx] = v;
  }
  __syncthreads();
#pragma unroll
  for (int i = 0; i < 16; ++i) {
    const int n = ty + 4 * i;
    Wt[(size_t)(n0 + n) * ldw + k0 + tx] = f2bf(s[tx * 65 + n]);
  }
}

DI void convert_layer(const Params& p, int l, int bid, int nb, char* smem) {
  for (int it = bid; it < 3152; it += nb) {
    int t = it;
    if (t < 704) { convert_tile(p.w_in + (size_t)l * 1024 * IN_COLS, p.wb_in, HLD, 1024, IN_COLS, 0, nullptr, t % 16, t / 16, smem); continue; }
    t -= 704;
    if (t < 48) { convert_tile(p.w_uq + (size_t)l * 256 * 768, p.wb_uq, 256, 256, 768, 0, p.q_norm + l * 256, t % 4, t / 4, smem); continue; }
    t -= 48;
    if (t < 32) { convert_tile(p.w_ukv + (size_t)l * 128 * 1024, p.wb_ukv, 128, 128, 1024, 0, p.kv_norm + l * 128, t % 2, t / 2, smem); continue; }
    t -= 32;
    if (t < 256) { convert_tile(p.w_out + (size_t)l * 1024 * 1024, p.wb_out, HLD, 1024, 1024, 0, nullptr, t % 16, t / 16, smem); continue; }
    t -= 256;
    if (t < 1408) { convert_tile(p.w_ffi + (size_t)l * 1024 * 5632, p.wb_ffi, HLD, 1024, 5632, 1, nullptr, t % 16, t / 16, smem); continue; }
    t -= 1408;
    convert_tile(p.w_ffo + (size_t)l * FFD * 1024, p.wb_ffo, PLD, FFD, 1024, 0, nullptr, t % 44, t / 44, smem);
  }
}

DI void phase0_misc(const Params& p, int bid, int nb, char* smem) {
  const int tid = tidx();
  if (bid < 384) {
    float* sc = (float*)smem;
    float* red = sc + 5 * 1024;
    __syncthreads();
    for (int e = tid; e < 5 * 1024; e += 256) {
      const int v = e >> 10, k = e & 1023;
      const float x = v == 0 ? p.c_ctx[k] : p.c[(v - 1) * 1024 + k];
      sc[e] = siluf_(x);
    }
    __syncthreads();
    for (int it = bid; it < 384; it += nb) {
      const int l = it / 96, n0 = (it % 96) * 64;
      const int col = tid & 63, ks = tid >> 6;
      float a[5] = {0.f, 0.f, 0.f, 0.f, 0.f};
      const float* wp = p.w_mod + (size_t)l * 1024 * 6144 + n0 + col;
      for (int k = ks * 256; k < ks * 256 + 256; ++k) {
        const float wv = wp[(size_t)k * 6144];
#pragma unroll
        for (int v = 0; v < 5; ++v) a[v] += sc[v * 1024 + k] * wv;
      }
      __syncthreads();
#pragma unroll
      for (int v = 0; v < 5; ++v) red[(ks * 5 + v) * 64 + col] = a[v];
      __syncthreads();
      for (int e = tid; e < 320; e += 256) {
        const int v = e >> 6, cc = e & 63;
        const float sum = red[(0 * 5 + v) * 64 + cc] + red[(1 * 5 + v) * 64 + cc] + red[(2 * 5 + v) * 64 + cc] +
                          red[(3 * 5 + v) * 64 + cc];
        p.modv[((size_t)l * 5 + v) * 6144 + n0 + cc] = sum + p.b_mod[l * 6144 + n0 + cc];
      }
    }
  }
  const int gt = bid * 256 + tid, gn = nb * 256;
  for (int c = gt; c < 256; c += gn) {
    float x[4], mx = -1e30f;
    for (int l = 0; l < 4; ++l) { x[l] = p.lb_logits[l * 256 + c]; mx = fmaxf(mx, x[l]); }
    float s = 0.f;
    for (int l = 0; l < 4; ++l) { x[l] = __expf(x[l] - mx); s += x[l]; }
    float cum = 0.f;
    for (int l = 0; l < 4; ++l) {
      const float pl = x[l] / s;
      if (l > 0) cum += pl;
      p.lbs[l * 256 + c] = cum;
    }
  }
  for (int e = gt; e < 512; e += gn) {
    const int pos = e >> 3, i = e & 7;
    const float f = exp2f(-(float)i * 0.125f * 13.287712379549449f);
    const float ang = (float)pos * f;
    p.rope[e] = __cosf(ang);
    p.rope[512 + e] = __sinf(ang);
  }
  for (int e = gt; e < 4 * 4 * 512 * 128; e += gn) {
    const int k = e & 127, t = (e >> 7) & 511, b = (e >> 16) & 3, l = e >> 18;
    const float cv = p.cache_ckv[(((size_t)b * 4 + l) * 512 + t) * 128 + k] / p.kv_norm[l * 128 + k];
    asm volatile("s_waitcnt vmcnt(0)" ::: "memory");
    p.ckvc[e] = f2bf(cv);
  }
  for (int e = gt; e < 4 * 4 * 512 * 32; e += gn) {
    const int k = e & 31, t = (e >> 5) & 511, b = (e >> 14) & 3, l = e >> 16;
    const float kv = p.cache_kpe[(((size_t)b * 4 + l) * 512 + t) * 32 + k];
    asm volatile("s_waitcnt vmcnt(0)" ::: "memory");
    p.kpec[e] = f2bf(kv);
  }
}

DI void phase0_h(const Params& p, int bid, int nb) {
  const int tid = tidx(); const int lane = tid & 63, gw = bid * 4 + (tid >> 6), nw = nb * 4;
  for (int row = gw; row < NTOK; row += nw) {
    const float* src = row < NCTX ? p.x_prompt + (size_t)row * DM : p.x_sample + (size_t)(row - NCTX) * DM;
    const float* mv = p.modv + (size_t)cvec_of(row) * 6144;
    float4 x[4], sh[4], sc[4];
#pragma unroll
    for (int i = 0; i < 4; ++i) {
      const int col = i * 256 + lane * 4;
      x[i] = *(const float4*)(src + col);
      sh[i] = *(const float4*)(mv + col);
      sc[i] = *(const float4*)(mv + 1024 + col);
    }
    asm volatile("s_waitcnt vmcnt(0)" ::: "memory");
#pragma unroll
    for (int i = 0; i < 4; ++i) {
      const int col = i * 256 + lane * 4;
      bf16x4 o;
      o[0] = (short)f2bf(x[i].x * (1.f + sc[i].x) + sh[i].x);
      o[1] = (short)f2bf(x[i].y * (1.f + sc[i].y) + sh[i].y);
      o[2] = (short)f2bf(x[i].z * (1.f + sc[i].z) + sh[i].z);
      o[3] = (short)f2bf(x[i].w * (1.f + sc[i].w) + sh[i].w);
      *(bf16x4*)(p.hbuf + (size_t)row * HLD + col) = o;
    }
  }
}

DI float wave_sum(float v) {
#pragma unroll
  for (int o = 32; o > 0; o >>= 1) v += __shfl_xor(v, o);
  return v;
}
DI float wave_max(float v) {
#pragma unroll
  for (int o = 32; o > 0; o >>= 1) v = fmaxf(v, __shfl_xor(v, o));
  return v;
}

DI void ln_phase(const Params& p, int l, int which, int bid, int nb) {
  const int tid = tidx(); const int lane = tid & 63, gw = bid * 4 + (tid >> 6), nw = nb * 4;
  float* X = which == 1 ? p.X1 : p.out;
  float2* S = which == 1 ? p.S1 : p.S2;
  const float* gam = (which == 1 ? p.ln1_g : p.ln2_g) + l * DM;
  const float* bet = (which == 1 ? p.ln1_b : p.ln2_b) + l * DM;
  const bool wh = which == 1 || l < 3;
  const bool wx = which == 2 && l == 3;
  const int ml = which == 1 ? l : l + 1;
  const int shoff = which == 1 ? 3072 : 0;
  auto process = [&](float4 (&x)[4], int row) {
    float* xr = X + (size_t)row * DM;
    float s = 0.f;
#pragma unroll
    for (int i = 0; i < 4; ++i) s += x[i].x + x[i].y + x[i].z + x[i].w;
    const float mu = wave_sum(s) * (1.f / 1024.f);
    float v = 0.f;
#pragma unroll
    for (int i = 0; i < 4; ++i) {
      x[i].x -= mu; x[i].y -= mu; x[i].z -= mu; x[i].w -= mu;
      v += x[i].x * x[i].x + x[i].y * x[i].y + x[i].z * x[i].z + x[i].w * x[i].w;
    }
    const float rstd = rsqrtf(wave_sum(v) * (1.f / 1024.f) + EPSF);
    if (lane == 0) S[row] = make_float2(mu, rstd);
    const float* mv = p.modv + ((size_t)ml * 5 + cvec_of(row)) * 6144 + shoff;
#pragma unroll
    for (int i = 0; i < 4; ++i) {
      const int col = i * 256 + lane * 4;
      const float4 g = *(const float4*)(gam + col), b = *(const float4*)(bet + col);
      float4 y;
      y.x = x[i].x * rstd * g.x + b.x; y.y = x[i].y * rstd * g.y + b.y;
      y.z = x[i].z * rstd * g.z + b.z; y.w = x[i].w * rstd * g.w + b.w;
      if (wx) *(float4*)(xr + col) = y;
      if (wh) {
        const float4 sh = *(const float4*)(mv + col), sc = *(const float4*)(mv + 1024 + col);
        bf16x4 o;
        o[0] = (short)f2bf(y.x * (1.f + sc.x) + sh.x);
        o[1] = (short)f2bf(y.y * (1.f + sc.y) + sh.y);
        o[2] = (short)f2bf(y.z * (1.f + sc.z) + sh.z);
        o[3] = (short)f2bf(y.w * (1.f + sc.w) + sh.w);
        *(bf16x4*)(p.hbuf + (size_t)row * HLD + col) = o;
      }
    }
  };
  for (int row = gw; row < NTOK; row += 2 * nw) {
    const int row2 = row + nw;
    const bool has2 = row2 < NTOK;
    float4 xa[4], xb[4];
#pragma unroll
    for (int i = 0; i < 4; ++i) xa[i] = *(const float4*)(X + (size_t)row * DM + i * 256 + lane * 4);
    if (has2) {
#pragma unroll
      for (int i = 0; i < 4; ++i) xb[i] = *(const float4*)(X + (size_t)row2 * DM + i * 256 + lane * 4);
    }
    asm volatile("s_waitcnt vmcnt(0)" ::: "memory");
    process(xa, row);
    if (has2) process(xb, row2);
  }
}

DI int scan_idx(int dir, int hd, int tc) { return (dir * 4 + hd) * NTC + tc; }

DI void mlstm_local(const Params& p, int tc, int hd, char* smem) {
  bf16_t* sKT = (bf16_t*)smem;
  bf16_t* sVT = sKT + 2 * 64 * 72;
  float* sW = (float*)(sVT + 64 * 72);
  const int tid = tidx(), lane = tid & 63, w = tid >> 6;
  const int row0 = tc * 64;
  __syncthreads();
  if (w < 2) {
    const int dir = w;
    const int t = dir ? 63 - lane : lane;
    const float* gp = p.gates + (size_t)(row0 + t) * 16;
    const float ig = gp[dir * 4 + hd], fg = gp[8 + dir * 4 + hd];
    const float lf = fminf(fg, 0.f) - log1pf(__expf(-fabsf(fg)));
    float b = lf;
#pragma unroll
    for (int o = 1; o < 64; o <<= 1) {
      const float v = __shfl_up(b, o);
      if (lane >= o) b += v;
    }
    const float g = __shfl(b, 63);
    const float u = g - b + ig;
    const float um = wave_max(u);
    sW[dir * 64 + t] = __expf(u - um);
    if (lane == 0) {
      p.Mg[scan_idx(dir, hd, tc)] = g;
      p.Mumax[scan_idx(dir, hd, tc)] = um;
    }
  }
  __syncthreads();
  {
    const int t = tid >> 2, c0 = (tid & 3) * 16;
    const bf16_t* kp = p.proj + (size_t)(row0 + t) * PLD + C_MK + hd * 64 + c0;
    const bf16_t* vp = p.proj + (size_t)(row0 + t) * PLD + C_MV + hd * 64 + c0;
    const float w0 = sW[t], w1 = sW[64 + t];
#pragma unroll
    for (int q = 0; q < 2; ++q) {
      const bf16x8 kv = *(const bf16x8*)(kp + q * 8);
      const bf16x8 vv = *(const bf16x8*)(vp + q * 8);
#pragma unroll
      for (int j = 0; j < 8; ++j) {
        const int d = c0 + q * 8 + j;
        const float kf = bfs(kv[j]) * 0.125f;
        sKT[d * 72 + t] = f2bf(kf * w0);
        sKT[64 * 72 + d * 72 + t] = f2bf(kf * w1);
        sVT[d * 72 + t] = (bf16_t)vv[j];
      }
    }
  }
  __syncthreads();
  if (tid < 128) {
    const int dir = tid >> 6, d = tid & 63;
    float s = 0.f;
    for (int t = 0; t < 64; ++t) s += bf2f(sKT[dir * 64 * 72 + d * 72 + t]);
    p.Mn[(size_t)scan_idx(dir, hd, tc) * 64 + d] = s;
  }
  const int I = w >> 1, J = w & 1, r = lane & 31, h = lane >> 5;
#pragma unroll
  for (int dir = 0; dir < 2; ++dir) {
    f32x16 acc = zero16();
    wave_mma1(acc, sKT + dir * 64 * 72 + I * 32 * 72, 72, sVT + J * 32 * 72, 72, 64, lane);
    bf16_t* U = p.MU + (size_t)scan_idx(dir, hd, tc) * 4096;
#pragma unroll
    for (int reg = 0; reg < 16; ++reg) U[(I * 32 + crow(reg, h)) * 64 + J * 32 + r] = f2bf(acc[reg]);
  }
}

DI void state_item(const Params& p, int l, int item) {
  const int tid = tidx();
  const bool hg = item >= 576;
  if (hg) item -= 576;
  const int part = item & 1;
  int chain = item >> 1;
  chain = chain < 32 ? chain + 256 : chain - 32;
  const int hd = chain & 3, dir = (chain >> 2) & 1, seq = chain >> 3;
  const int e0 = (part * 256 + tid) * 8;
  const bool ctx = seq < 32;
  const int b = ctx ? seq : seq - 32;
  const int nc = ctx ? 4 : 64;
  const int tcb = ctx ? seq * 4 : 128 + b * 64;
  const int sidx = ((b * 4 + l) * 2 + dir) * 4 + hd;
  bf16_t* U = hg ? p.HU : p.MU;
  const bool don = (!hg) && part == 0 && tid < 8;
  float C[8], n[8], m = 0.f;
#pragma unroll
  for (int j = 0; j < 8; ++j) { C[j] = 0.f; n[j] = 0.f; }
  if (!ctx) {
    const float* src = (hg ? p.st_S : p.st_C) + (size_t)sidx * 4096 + e0;
    const float4 c0 = *(const float4*)src, c1 = *(const float4*)(src + 4);
    C[0] = c0.x; C[1] = c0.y; C[2] = c0.z; C[3] = c0.w; C[4] = c1.x; C[5] = c1.y; C[6] = c1.z; C[7] = c1.w;
    if (!hg) {
      m = p.st_m[sidx];
      if (don) {
#pragma unroll
        for (int j = 0; j < 8; ++j) n[j] = p.st_n[sidx * 64 + tid * 8 + j];
      }
    }
  }
  const int crow_ = e0 >> 6;
  for (int c0 = 0; c0 < nc; c0 += 4) {
    u32x4 u[4];
    float g[4], um[4];
    int idx[4];
#pragma unroll
    for (int q = 0; q < 4; ++q) {
      const int c = c0 + q;
      const int tc = dir ? tcb + nc - 1 - c : tcb + c;
      idx[q] = scan_idx(dir, hd, tc);
      u[q] = *(const u32x4*)(U + (size_t)idx[q] * 4096 + e0);
      if (hg) {
        g[q] = p.Hd[(size_t)idx[q] * 64 + crow_];
        um[q] = 0.f;
      } else {
        g[q] = p.Mg[idx[q]];
        um[q] = p.Mumax[idx[q]];
      }
    }
#pragma unroll
    for (int q = 0; q < 4; ++q) {
      u32x4 o;
#pragma unroll
      for (int j = 0; j < 4; ++j) o[j] = (unsigned)f2bf(C[2 * j]) | ((unsigned)f2bf(C[2 * j + 1]) << 16);
      *(u32x4*)(U + (size_t)idx[q] * 4096 + e0) = o;
      float uf[8];
#pragma unroll
      for (int j = 0; j < 4; ++j) { uf[2 * j] = __uint_as_float(u[q][j] << 16); uf[2 * j + 1] = __uint_as_float(u[q][j] & 0xffff0000u); }
      if (hg) {
#pragma unroll
        for (int j = 0; j < 8; ++j) C[j] = g[q] * C[j] + uf[j];
      } else {
        const float mnew = fmaxf(g[q] + m, um[q]);
        const float sc = __expf(g[q] + m - mnew), su = __expf(um[q] - mnew);
        if (don) {
          float* np = p.Mn + (size_t)idx[q] * 64 + tid * 8;
#pragma unroll
          for (int j = 0; j < 8; ++j) { const float nl = np[j]; np[j] = n[j]; n[j] = sc * n[j] + su * nl; }
        }
        if (part == 0 && tid == 0) p.Mm[idx[q]] = m;
#pragma unroll
        for (int j = 0; j < 8; ++j) C[j] = sc * C[j] + su * uf[j];
        m = mnew;
      }
    }
  }
  if (ctx) {
    float* dst = p.out + (hg ? O_S : O_C) + (size_t)sidx * 4096 + e0;
    *(float4*)dst = make_float4(C[0], C[1], C[2], C[3]);
    *(float4*)(dst + 4) = make_float4(C[4], C[5], C[6], C[7]);
    if (!hg) {
      if (don) {
#pragma unroll
        for (int j = 0; j < 8; ++j) p.out[O_N + sidx * 64 + tid * 8 + j] = n[j];
      }
      if (part == 0 && tid == 0) p.out[O_M + sidx] = m;
    }
  }
}

DI void mlstm_out(const Params& p, int l, int tc, int hd, char* smem) {
  bf16_t* sQ = (bf16_t*)smem;
  bf16_t* sK = sQ + 64 * 72;
  bf16_t* sVT = sK + 64 * 72;
  bf16_t* sCT = sVT + 64 * 72;
  bf16_t* sP = sCT + 64 * 72;
  float* fb = (float*)(sP + 64 * 72);
  float *sb = fb, *sib = fb + 64, *smt = fb + 128, *sws = fb + 192, *sden = fb + 256, *sn = fb + 320;
  float* sH = (float*)smem;
  const int tid = tidx(), lane = tid & 63, w = tid >> 6;
  const int I = w >> 1, J = w & 1, r = lane & 31, h = lane >> 5;
  const int row0 = tc * 64;
  __syncthreads();
  {
    const int t = tid >> 2, c0 = (tid & 3) * 16;
    const bf16_t* qp = p.proj + (size_t)(row0 + t) * PLD + C_MQ + hd * 64 + c0;
    const bf16_t* kp = p.proj + (size_t)(row0 + t) * PLD + C_MK + hd * 64 + c0;
    const bf16_t* vp = p.proj + (size_t)(row0 + t) * PLD + C_MV + hd * 64 + c0;
#pragma unroll
    for (int q = 0; q < 2; ++q) {
      *(bf16x8*)(sQ + t * 72 + c0 + q * 8) = *(const bf16x8*)(qp + q * 8);
      const bf16x8 kv = *(const bf16x8*)(kp + q * 8);
      const bf16x8 vv = *(const bf16x8*)(vp + q * 8);
#pragma unroll
      for (int j = 0; j < 8; ++j) {
        const int d = c0 + q * 8 + j;
        sK[t * 72 + d] = f2bf(bfs(kv[j]) * 0.125f);
        sVT[d * 72 + t] = (bf16_t)vv[j];
      }
    }
  }
  f32x16 hacc = zero16();
  for (int dir = 0; dir < 2; ++dir) {
    const int idx = scan_idx(dir, hd, tc);
    if (w == 0) {
      const int t = dir ? 63 - lane : lane;
      const float* gp = p.gates + (size_t)(row0 + t) * 16;
      const float ig = gp[dir * 4 + hd], fg = gp[8 + dir * 4 + hd];
      const float lf = fminf(fg, 0.f) - log1pf(__expf(-fabsf(fg)));
      float b = lf;
#pragma unroll
      for (int o = 1; o < 64; o <<= 1) {
        const float v = __shfl_up(b, o);
        if (lane >= o) b += v;
      }
      const float ib = ig - b;
      float pm = ib;
#pragma unroll
      for (int o = 1; o < 64; o <<= 1) {
        const float v = __shfl_up(pm, o);
        if (lane >= o) pm = fmaxf(pm, v);
      }
      const float m0 = p.Mm[idx];
      const float mt = fmaxf(b + m0, b + pm);
      sb[t] = b; sib[t] = ib; smt[t] = mt; sws[t] = __expf(b + m0 - mt);
    } else {
      const bf16_t* Cs = p.MU + (size_t)idx * 4096;
      for (int e = tid - 64; e < 4096; e += 192) {
        const int d = e >> 6, ee = e & 63;
        sCT[ee * 72 + d] = Cs[e];
      }
      if (w == 1) sn[lane] = p.Mn[(size_t)idx * 64 + lane];
    }
    __syncthreads();
    const bool skip = dir ? (I == 1 && J == 0) : (I == 0 && J == 1);
    {
      f32x16 s = zero16();
      if (!skip) wave_mma1(s, sQ + I * 32 * 72, 72, sK + J * 32 * 72, 72, 64, lane);
      const int sg = J * 32 + r;
      const float ibs = sib[sg];
#pragma unroll
      for (int reg = 0; reg < 16; ++reg) {
        const int t = I * 32 + crow(reg, h);
        const bool keep = dir ? (sg >= t) : (sg <= t);
        const float pv = keep ? s[reg] * __expf(sb[t] + ibs - smt[t]) : 0.f;
        sP[t * 72 + sg] = f2bf(pv);
      }
    }
    f32x16 acc = zero16();
    wave_mma1(acc, sQ + I * 32 * 72, 72, sCT + J * 32 * 72, 72, 64, lane);
#pragma unroll
    for (int reg = 0; reg < 16; ++reg) acc[reg] *= sws[I * 32 + crow(reg, h)];
    __syncthreads();
    if (tid < 64) {
      const int t = tid;
      float qn = 0.f, ps = 0.f;
      for (int d = 0; d < 64; ++d) {
        qn += bf2f(sQ[t * 72 + d]) * sn[d];
        ps += bf2f(sP[t * 72 + d]);
      }
      const float den = sws[t] * qn + ps;
      sden[t] = __builtin_amdgcn_rcpf(fmaxf(fabsf(den), __expf(-smt[t])));
    }
    wave_mma1(acc, sP + I * 32 * 72, 72, sVT + J * 32 * 72, 72, 64, lane);
    __syncthreads();
#pragma unroll
    for (int reg = 0; reg < 16; ++reg) hacc[reg] += acc[reg] * sden[I * 32 + crow(reg, h)];
    __syncthreads();
  }
#pragma unroll
  for (int reg = 0; reg < 16; ++reg) sH[(I * 32 + crow(reg, h)) * 64 + J * 32 + r] = hacc[reg];
  __syncthreads();
  {
    const int t = tid >> 2, c0 = (tid & 3) * 16;
    float v[16], s = 0.f;
#pragma unroll
    for (int j = 0; j < 16; ++j) { v[j] = sH[t * 64 + c0 + j]; s += v[j]; }
    s += __shfl_xor(s, 1); s += __shfl_xor(s, 2);
    const float mu = s * (1.f / 64.f);
    float q = 0.f;
#pragma unroll
    for (int j = 0; j < 16; ++j) { v[j] -= mu; q += v[j] * v[j]; }
    q += __shfl_xor(q, 1); q += __shfl_xor(q, 2);
    const float rstd = rsqrtf(q * (1.f / 64.f) + EPSF);
    const bf16_t* mo = p.proj + (size_t)(row0 + t) * PLD + C_MO + hd * 64 + c0;
    const float* ng = p.ml_norm + l * 256 + hd * 64 + c0;
    bf16_t* dst = p.hbuf + (size_t)(row0 + t) * HLD + 512 + hd * 64 + c0;
    const bf16x8 mv0 = *(const bf16x8*)(mo), mv1 = *(const bf16x8*)(mo + 8);
    float ngv[16];
#pragma unroll
    for (int j = 0; j < 16; ++j) ngv[j] = ng[j];
    asm volatile("s_waitcnt vmcnt(0)" ::: "memory");
#pragma unroll
    for (int q2 = 0; q2 < 2; ++q2) {
      const bf16x8 mv = q2 ? mv1 : mv0;
      bf16x8 o;
#pragma unroll
      for (int j = 0; j < 8; ++j)
        o[j] = (short)f2bf(v[q2 * 8 + j] * rstd * ngv[q2 * 8 + j] * sigmoidf_(bfs(mv[j])));
      *(bf16x8*)(dst + q2 * 8) = o;
    }
  }
}

DI void hgrn_gate(float fr, float lbv, float& kk, float& lg) {
  const float sg = sigmoidf_(fr);
  const float f = lbv + (1.f - lbv) * sg;
  kk = (1.f - lbv) * sigmoidf_(-fr);
  lg = __logf(fmaxf(f, 1e-30f));
}

DI float hgrn_cumsum(float* sBc, float* sTot, int dir, int tid, float* ref31) {
  const int c = tid & 63, seg = tid >> 6;
  float v[16];
#pragma unroll
  for (int i = 0; i < 16; ++i) {
    const int sp = seg * 16 + i;
    const int tt = dir ? 63 - sp : sp;
    v[i] = sBc[tt * 64 + c];
  }
  float run = 0.f;
#pragma unroll
  for (int i = 0; i < 16; ++i) { run += v[i]; v[i] = run; }
  sTot[seg * 64 + c] = run;
  __syncthreads();
  const float t0 = sTot[c], t1 = sTot[64 + c], t2 = sTot[128 + c], t3 = sTot[192 + c];
  const float off = (seg > 0 ? t0 : 0.f) + (seg > 1 ? t1 : 0.f) + (seg > 2 ? t2 : 0.f);
#pragma unroll
  for (int i = 0; i < 16; ++i) {
    const int sp = seg * 16 + i;
    const int tt = dir ? 63 - sp : sp;
    sBc[tt * 64 + c] = v[i] + off;
  }
  *ref31 = v[15] + off;
  return ((t0 + t1) + t2) + t3;
}

DI void hgrn_local(const Params& p, int l, int tc, int hd, char* smem) {
  float* sBc = (float*)smem;
  bf16_t* sKG = (bf16_t*)(sBc + 4096);
  bf16_t* sVT = sKG + 64 * 72;
  float* sGL = (float*)(sVT + 64 * 72);
  const int tid = tidx(), lane = tid & 63, w = tid >> 6;
  const int I = w >> 1, J = w & 1, r = lane & 31, h = lane >> 5;
  const int row0 = tc * 64;
  const int t = tid >> 2, c0 = (tid & 3) * 16;
  __syncthreads();
  {
    const bf16_t* vp = p.proj + (size_t)(row0 + t) * PLD + C_GI + hd * 64 + c0;
#pragma unroll
    for (int q = 0; q < 2; ++q) {
      const bf16x8 vv = *(const bf16x8*)(vp + q * 8);
#pragma unroll
      for (int j = 0; j < 8; ++j) sVT[(c0 + q * 8 + j) * 72 + t] = (bf16_t)vv[j];
    }
  }
  for (int dir = 0; dir < 2; ++dir) {
    const int idx = scan_idx(dir, hd, tc);
    float kk[16];
    {
      const bf16_t* fp = p.proj + (size_t)(row0 + t) * PLD + (dir ? C_GFB : C_GFF) + hd * 64 + c0;
      const float* lbp = p.lbs + l * 256 + hd * 64 + c0;
#pragma unroll
      for (int q = 0; q < 2; ++q) {
        const bf16x8 fv = *(const bf16x8*)(fp + q * 8);
#pragma unroll
        for (int j = 0; j < 8; ++j) {
          float lg;
          hgrn_gate(bfs(fv[j]), lbp[q * 8 + j], kk[q * 8 + j], lg);
          sBc[t * 64 + c0 + q * 8 + j] = lg;
        }
      }
    }
    __syncthreads();
    {
      float r31;
      const float tot = hgrn_cumsum(sBc, sGL + 64, dir, tid, &r31);
      if (tid < 64) {
        sGL[tid] = tot;
        p.Hd[(size_t)idx * 64 + tid] = __expf(tot);
      }
    }
    __syncthreads();
#pragma unroll
    for (int j = 0; j < 16; ++j) {
      const int c = c0 + j;
      sKG[c * 72 + t] = f2bf(kk[j] * __expf(sGL[c] - sBc[t * 64 + c]));
    }
    __syncthreads();
    f32x16 acc = zero16();
    wave_mma1(acc, sKG + I * 32 * 72, 72, sVT + J * 32 * 72, 72, 64, lane);
    bf16_t* U = p.HU + (size_t)idx * 4096;
#pragma unroll
    for (int reg = 0; reg < 16; ++reg) U[(I * 32 + crow(reg, h)) * 64 + J * 32 + r] = f2bf(acc[reg]);
    __syncthreads();
  }
}

DI void hgrn_out(const Params& p, int l, int tc, int hd, char* smem) {
  float* sBc = (float*)smem;
  bf16_t* sVT = (bf16_t*)(sBc + 4096);
  bf16_t* sST = sVT + 64 * 72;
  bf16_t* sQ = sST + 64 * 72;
  bf16_t* sQ1 = sQ + 64 * 72;
  bf16_t* sK = sQ1 + 32 * 72;
  bf16_t* sK1 = sK + 64 * 72;
  float* sRef = (float*)(sK1 + 32 * 72);
  const int tid = tidx(), lane = tid & 63, w = tid >> 6;
  const int I = w >> 1, J = w & 1, r = lane & 31, h = lane >> 5;
  const int row0 = tc * 64;
  const int t = tid >> 2, c0 = (tid & 3) * 16;
  __syncthreads();
  {
    const bf16_t* vp = p.proj + (size_t)(row0 + t) * PLD + C_GI + hd * 64 + c0;
#pragma unroll
    for (int q = 0; q < 2; ++q) {
      const bf16x8 vv = *(const bf16x8*)(vp + q * 8);
#pragma unroll
      for (int j = 0; j < 8; ++j) sVT[(c0 + q * 8 + j) * 72 + t] = (bf16_t)vv[j];
    }
  }
  f32x16 oacc = zero16();
  for (int dir = 0; dir < 2; ++dir) {
    const int idx = scan_idx(dir, hd, tc);
    float kk[16], qv[16];
    {
      const bf16_t* fp = p.proj + (size_t)(row0 + t) * PLD + (dir ? C_GFB : C_GFF) + hd * 64 + c0;
      const bf16_t* qp = p.proj + (size_t)(row0 + t) * PLD + C_GQ + hd * 64 + c0;
      const float* lbp = p.lbs + l * 256 + hd * 64 + c0;
#pragma unroll
      for (int q = 0; q < 2; ++q) {
        const bf16x8 fv = *(const bf16x8*)(fp + q * 8);
        const bf16x8 qq = *(const bf16x8*)(qp + q * 8);
#pragma unroll
        for (int j = 0; j < 8; ++j) {
          float lg;
          hgrn_gate(bfs(fv[j]), lbp[q * 8 + j], kk[q * 8 + j], lg);
          sBc[t * 64 + c0 + q * 8 + j] = lg;
          qv[q * 8 + j] = siluf_(bfs(qq[j]));
        }
      }
      const bf16_t* Ss = p.HU + (size_t)idx * 4096;
#pragma unroll
      for (int i = 0; i < 16; ++i) {
        const int e = i * 256 + tid;
        sST[(e & 63) * 72 + (e >> 6)] = Ss[e];
      }
    }
    __syncthreads();
    {
      float r31;
      (void)hgrn_cumsum(sBc, sRef + 64, dir, tid, &r31);
      if ((tid >> 6) == 1) sRef[tid & 63] = r31;
    }
    __syncthreads();
    const int sb2 = dir ? 0 : 1;
    {
      const bool second = (t >> 5) == sb2;
#pragma unroll
      for (int j = 0; j < 16; ++j) {
        const int c = c0 + j;
        const float bc = sBc[t * 64 + c];
        const float rf = sRef[c];
        sQ[t * 72 + c] = f2bf(qv[j] * __expf(bc));
        if (second) {
          sQ1[(t & 31) * 72 + c] = f2bf(qv[j] * __expf(bc - rf));
          sK[t * 72 + c] = f2bf(kk[j] * __expf(rf - bc));
        } else {
          sK[t * 72 + c] = f2bf(kk[j] * __expf(-bc));
          sK1[(t & 31) * 72 + c] = f2bf(kk[j] * __expf(rf - bc));
        }
      }
    }
    __syncthreads();
    f32x16 a = zero16();
    if (I == J) {
      wave_mma1(a, (I == sb2) ? sQ1 : sQ + I * 32 * 72, 72, sK + J * 32 * 72, 72, 64, lane);
#pragma unroll
      for (int reg = 0; reg < 16; ++reg) {
        const int tl = crow(reg, h);
        const bool keep = dir ? (r >= tl) : (r <= tl);
        if (!keep) a[reg] = 0.f;
      }
    } else if (I == sb2) {
      wave_mma1(a, sQ1, 72, sK1, 72, 64, lane);
    }
    wave_mma1(oacc, sQ + I * 32 * 72, 72, sST + J * 32 * 72, 72, 64, lane);
    __syncthreads();
#pragma unroll
    for (int reg = 0; reg < 16; ++reg) sQ[(I * 32 + crow(reg, h)) * 72 + J * 32 + r] = f2bf(a[reg]);
    __syncthreads();
    wave_mma1(oacc, sQ + I * 32 * 72, 72, sVT + J * 32 * 72, 72, 64, lane);
    __syncthreads();
  }
  float* sO = sBc;
#pragma unroll
  for (int reg = 0; reg < 16; ++reg) sO[(I * 32 + crow(reg, h)) * 64 + J * 32 + r] = oacc[reg];
  __syncthreads();
  {
    float v[16], q = 0.f;
#pragma unroll
    for (int j = 0; j < 16; ++j) { v[j] = sO[t * 64 + c0 + j]; q += v[j] * v[j]; }
    q += __shfl_xor(q, 1); q += __shfl_xor(q, 2);
    const float rstd = rsqrtf(q * (1.f / 64.f) + EPSF);
    const bf16_t* gg = p.proj + (size_t)(row0 + t) * PLD + C_GG + hd * 64 + c0;
    const float* ng = p.hg_norm + l * 256 + hd * 64 + c0;
    bf16_t* dst = p.hbuf + (size_t)(row0 + t) * HLD + 768 + hd * 64 + c0;
    const bf16x8 gv0 = *(const bf16x8*)(gg), gv1 = *(const bf16x8*)(gg + 8);
    float ngv[16];
#pragma unroll
    for (int j = 0; j < 16; ++j) ngv[j] = ng[j];
    asm volatile("s_waitcnt vmcnt(0)" ::: "memory");
#pragma unroll
    for (int q2 = 0; q2 < 2; ++q2) {
      const bf16x8 gv = q2 ? gv1 : gv0;
      bf16x8 o;
#pragma unroll
      for (int j = 0; j < 8; ++j) o[j] = (short)f2bf(v[q2 * 8 + j] * rstd * ngv[q2 * 8 + j] * siluf_(bfs(gv[j])));
      *(bf16x8*)(dst + q2 * 8) = o;
    }
  }
}

DI void attn_item(const Params& p, int l, int item, char* smem) {
  bf16_t* sK = (bf16_t*)smem;
  bf16_t* sV = sK + 64 * 104;
  const int tid = tidx(), lane = tid & 63, w = tid >> 6;
  const int r = lane & 31, h = lane >> 5;
  int b, hd, tok0, nk, vld, krow_base;
  const bf16_t* Vt;
  bool lat;
  if (item < 512) {
    lat = true; b = item >> 7; hd = (item >> 4) & 7; const int qb = item & 15;
    tok0 = NCTX + b * 4096 + qb * 256; nk = 4608; vld = 4608;
    Vt = p.VtL + (size_t)((b * 8 + hd) * 64) * 4608; krow_base = NCTX + b * 4096;
  } else {
    const int it = item - 512;
    lat = false; b = it >> 3; hd = it & 7;
    tok0 = b * 256; nk = 256; vld = 256;
    Vt = p.VtC + (size_t)((b * 8 + hd) * 64) * 256; krow_base = b * 256;
  }
  const int q0 = tok0 + w * 64;
  bf16x8 bq[2][6];
#pragma unroll
  for (int g = 0; g < 2; ++g)
#pragma unroll
    for (int s = 0; s < 6; ++s)
      bq[g][s] = *(const bf16x8*)(p.Q + (size_t)(q0 + g * 32 + r) * 768 + hd * 96 + 16 * s + 8 * h);
  f32x16 o[2][2];
#pragma unroll
  for (int g = 0; g < 2; ++g) { o[g][0] = zero16(); o[g][1] = zero16(); }
  float m[2] = {-1e30f, -1e30f}, lsum[2] = {0.f, 0.f};
  u32x4 rk[2], rp, rv[2];
  const int nkeyA = tid >> 3, npartA = tid & 7;
  const int pkey = tid >> 2, ppart = tid & 3;
  auto gload = [&](int k0) {
    const bf16_t* pe_ptr;
    int pe_ld, krow;
    if (lat && k0 >= 4096) {
      krow = NTOK + b * 512 + (k0 - 4096);
      pe_ptr = p.kpec + ((size_t)(l * 4 + b) * 512 + (k0 - 4096)) * 32;
      pe_ld = 32;
    } else {
      krow = krow_base + k0;
      pe_ptr = p.proj + (size_t)krow * PLD + C_KPE;
      pe_ld = PLD;
    }
#pragma unroll
    for (int i = 0; i < 2; ++i) {
      rk[i] = *(const u32x4*)(p.Kn + ((size_t)(krow + nkeyA + i * 32) * 8 + hd) * 64 + npartA * 8);
      rv[i] = *(const u32x4*)(Vt + (size_t)(nkeyA + i * 32) * vld + k0 + npartA * 8);
    }
    rp = *(const u32x4*)(pe_ptr + (size_t)pkey * pe_ld + ppart * 8);
  };
  gload(0);
  for (int k0 = 0; k0 < nk; k0 += 64) {
    __syncthreads();
#pragma unroll
    for (int i = 0; i < 2; ++i) {
      *(u32x4*)(sK + (nkeyA + i * 32) * 104 + npartA * 8) = rk[i];
      *(u32x4*)(sV + (nkeyA + i * 32) * 72 + npartA * 8) = rv[i];
    }
    *(u32x4*)(sK + pkey * 104 + 64 + ppart * 8) = rp;
    __syncthreads();
    if (k0 + 64 < nk) gload(k0 + 64);
    f32x16 s[2][2];
#pragma unroll
    for (int kb = 0; kb < 2; ++kb) {
      s[0][kb] = zero16();
      s[1][kb] = zero16();
#pragma unroll
      for (int ks = 0; ks < 6; ++ks) {
        const bf16x8 a = *(const bf16x8*)(sK + (kb * 32 + r) * 104 + 16 * ks + 8 * h);
        s[0][kb] = mfma(a, bq[0][ks], s[0][kb]);
        s[1][kb] = mfma(a, bq[1][ks], s[1][kb]);
      }
    }
    __builtin_amdgcn_sched_barrier(0);
#pragma unroll
    for (int g = 0; g < 2; ++g) {
      float mx = m[g];
#pragma unroll
      for (int kb = 0; kb < 2; ++kb)
#pragma unroll
        for (int reg = 0; reg < 16; ++reg) mx = fmaxf(mx, s[g][kb][reg]);
      mx = fmaxf(mx, __shfl_xor(mx, 32));
      const bool changed = __any(mx > m[g]);
      float alpha = 1.f;
      if (changed) { alpha = __builtin_amdgcn_exp2f(m[g] - mx); m[g] = mx; }
      float ps = 0.f;
#pragma unroll
      for (int kb = 0; kb < 2; ++kb)
#pragma unroll
        for (int reg = 0; reg < 16; ++reg) {
          const float pv = __builtin_amdgcn_exp2f(s[g][kb][reg] - m[g]);
          s[g][kb][reg] = pv;
          ps += pv;
        }
      if (changed) {
        lsum[g] *= alpha;
#pragma unroll
        for (int i = 0; i < 2; ++i)
#pragma unroll
          for (int reg = 0; reg < 16; ++reg) o[g][i][reg] *= alpha;
      }
      lsum[g] += ps;
      bf16x8 pb[2][2];
#pragma unroll
      for (int kb = 0; kb < 2; ++kb)
#pragma unroll
        for (int s2 = 0; s2 < 2; ++s2) {
          u32x4 pw;
#pragma unroll
          for (int j = 0; j < 4; ++j) pw[j] = pk_bf16(s[g][kb][8 * s2 + 2 * j], s[g][kb][8 * s2 + 2 * j + 1]);
          pb[kb][s2] = __builtin_bit_cast(bf16x8, pw);
        }
      __builtin_amdgcn_sched_barrier(0);
#pragma unroll
      for (int kb = 0; kb < 2; ++kb) {
#pragma unroll
        for (int s2 = 0; s2 < 2; ++s2) {
#pragma unroll
          for (int i = 0; i < 2; ++i) {
            const bf16_t* vp = sV + (i * 32 + r) * 72 + kb * 32 + 16 * s2 + 4 * h;
            const bf16x4 lo = *(const bf16x4*)vp;
            const bf16x4 hi = *(const bf16x4*)(vp + 8);
            const bf16x8 av = __builtin_shufflevector(lo, hi, 0, 1, 2, 3, 4, 5, 6, 7);
            o[g][i] = mfma(av, pb[kb][s2], o[g][i]);
          }
        }
      }
      __builtin_amdgcn_sched_barrier(0);
    }
  }
#pragma unroll
  for (int g = 0; g < 2; ++g) {
    float lt = lsum[g];
    lt += __shfl_xor(lt, 32);
    const float inv = 1.f / lt;
    bf16_t* dst = p.hbuf + (size_t)(q0 + g * 32 + r) * HLD + hd * 64;
#pragma unroll
    for (int i = 0; i < 2; ++i)
#pragma unroll
      for (int gg = 0; gg < 4; ++gg) {
        u32x4 dummy;
        (void)dummy;
        bf16x4 pk;
#pragma unroll
        for (int q = 0; q < 4; ++q) pk[q] = (short)f2bf(o[g][i][4 * gg + q] * inv);
        *(bf16x4*)(dst + i * 32 + 8 * gg + 4 * h) = pk;
      }
  }
}

#define XB_TMO      128
#define XB_XCNT(j)  (256  + 64 * (j))
#define XB_XSUB(j)  (1280 + 64 * (j))
#define XB_XGEN(j)  (2304 + 64 * (j))
#define XB_TOP      3328
#define XB_TOPGEN   3392
#define XCD_BAR_WORDS 3456
#define XB_SPIN_CAP (1u << 22)
#define LAS __attribute__((address_space(3)))
DI unsigned xb_ld(unsigned* p) { return __hip_atomic_load(p, __ATOMIC_RELAXED, __HIP_MEMORY_SCOPE_AGENT); }
DI unsigned xb_add(unsigned* p, unsigned v) { return __hip_atomic_fetch_add(p, v, __ATOMIC_RELAXED, __HIP_MEMORY_SCOPE_AGENT); }
DI unsigned xb_xcc_id() { return (unsigned)__builtin_amdgcn_s_getreg((3 << 11) | 20) & 0xFu; }
#define XB_SPIN(cond, bar) do { unsigned _sp = 0; while (cond) { __builtin_amdgcn_s_sleep(1); \
    if ((++_sp & 255u) == 0u) { if (xb_ld(&(bar)[XB_TMO])) break; if (_sp > XB_SPIN_CAP) { atomicAdd(&(bar)[XB_TMO], 1u); break; } } } } while (0)
struct XcdBarrier { unsigned* bar; unsigned x; volatile LAS unsigned* st; };
DI XcdBarrier xcd_barrier_post(unsigned* bar, volatile LAS unsigned* st) {
  XcdBarrier b; b.bar = bar; b.x = 0u; b.st = st;
  if (threadIdx.x == 0) {
    const unsigned x = xb_xcc_id();
    st[2] = x;
    (void)xb_add(&bar[XB_XCNT(x)], 1u);
  }
  return b;
}
DI void xcd_barrier_complete(unsigned* bar, unsigned x, unsigned& nloc, unsigned& nx) {
  const unsigned G = gridDim.x * gridDim.y * gridDim.z;
  unsigned sum, cnt, mine, sp = 0u;
  for (;;) {
    sum = 0u; cnt = 0u; mine = 0u;
#pragma unroll
    for (unsigned j = 0; j < 16; ++j) { const unsigned c = xb_ld(&bar[XB_XCNT(j)]); sum += c; cnt += (c > 0u) ? 1u : 0u; mine = (j == x) ? c : mine; }
    if (sum == G) break;
    __builtin_amdgcn_s_sleep(1);
    if ((++sp & 255u) == 0u) { if (xb_ld(&bar[XB_TMO])) break; if (sp > XB_SPIN_CAP) { atomicAdd(&bar[XB_TMO], 1u); break; } }
  }
  nloc = mine > 0u ? mine : 1u; nx = cnt > 0u ? cnt : 1u;
}
DI void xcd_barrier(const XcdBarrier& b) {
  asm volatile("s_waitcnt vmcnt(0)" ::: "memory");
  __syncthreads();
  if (threadIdx.x == 0) {
    unsigned* bar = b.bar;
    __builtin_amdgcn_s_waitcnt(0);
    unsigned nloc = b.st[0], nx = b.st[1];
    const unsigned bx = __builtin_amdgcn_readfirstlane(b.st[2]);
    if (nloc == 0u) { xcd_barrier_complete(bar, bx, nloc, nx); b.st[0] = nloc; b.st[1] = nx; }
    const unsigned old = xb_add(&bar[XB_XSUB(bx)], 1u);
    const unsigned gen = old / nloc;
    if (old + 1u == (gen + 1u) * nloc) {
      __builtin_amdgcn_fence(__ATOMIC_RELEASE, "agent");
      asm volatile("s_waitcnt vmcnt(0)" ::: "memory");
      const unsigned og = xb_add(&bar[XB_TOP], 1u);
      const unsigned tg = og / nx;
      if (og + 1u == (tg + 1u) * nx) xb_add(&bar[XB_TOPGEN], 1u);
      else XB_SPIN(xb_ld(&bar[XB_TOPGEN]) == tg, bar);
      __builtin_amdgcn_fence(__ATOMIC_ACQUIRE, "agent");
      xb_add(&bar[XB_XGEN(bx)], 1u);
      asm volatile("s_waitcnt vmcnt(0)" ::: "memory");
    } else {
      XB_SPIN(xb_ld(&bar[XB_XGEN(bx)]) == gen, bar);
      __builtin_amdgcn_fence(__ATOMIC_ACQUIRE, "agent");
      asm volatile("s_waitcnt vmcnt(0)" ::: "memory");
    }
  }
  __syncthreads();
}

DI void run_phase(const Params& p, int ph, int l, char* smem, int bid, int nb) {
  asm volatile("" : "+s"(bid));
  switch (ph) {
#if !defined(ONLY) || ONLY==0
    case 0:
      phase0_misc(p, bid, nb, smem);
      convert_layer(p, 0, bid, nb, smem);
      break;
#endif
#if !defined(ONLY) || ONLY==1
    case 1: phase0_h(p, bid, nb); break;
#endif
#if !defined(ONLY) || ONLY==2
    case 2: {
      EpiIn epi{&p, l};
      if (nb == 512) {
        for (int k = 0, mt, nt; tile_map(bid, nb, k, 88, 22, mt, nt); ++k)
          gemm_tile<4, false, false>(p.hbuf, HLD, p.wb_in, HLD, 1024, mt * 256, nt * 128, epi, smem, false);
        const int slot2 = ((bid >> 3) + 14) & 63;
        for (int k = 0, mt, nt; tile_map((bid & 7) | (slot2 << 3), nb, k, 16, 22, mt, nt); ++k)
          gemm_tile<2, false, true>(p.hbuf, HLD, p.wb_in, HLD, 1024, 22528 + mt * 128, nt * 128, epi, smem, false);
      } else {
        gemm_run<false>(p.hbuf, HLD, p.wb_in, HLD, 1024, 192, 22, epi, smem, bid, nb);
      }
    } break;
#endif
#if !defined(ONLY) || ONLY==3
    case 3: {
      EpiQ eq{&p};
      EpiKV ekv{&p};
      const bool rev = bid >= (nb >> 1);
#pragma unroll 1
      for (int stg = 0; stg < 4; ++stg) {
        const int which = rev ? 3 - stg : stg;
        if (which == 0) {
      for (int k = 0, mt, nt; tile_map(bid, nb, k, 192, 6, mt, nt); ++k)
        gemm_tile<2, true, false>(p.proj + C_CQ, PLD, p.wb_uq, 256, 256, mt * 128, nt * 128, eq, smem, false);
        } else if (which == 1) {
      for (int k = 0, mt, nt; tile_map((bid + (nb >> 1)) % nb, nb, k, 208, 8, mt, nt); ++k) {
        const int m0 = mt * 128;
        if (m0 < NTOK) {
          gemm_tile<2, true, false>(p.proj + C_CKV, PLD, p.wb_ukv, 128, 128, m0, nt * 128, ekv, smem, false);
          if (nt == 0 && m0 < NCTX) {
            const float* sRS = (const float*)(smem + 2 * 128 * 72 * 2);
            const int t0 = tidx();
#pragma unroll 1
            for (int e0 = t0; e0 < 128 * 128; e0 += 256 * 8) {
              float vals[8];
#pragma unroll
              for (int u = 0; u < 8; ++u) {
                const int e = e0 + u * 256;
                const int rl = e >> 7, k = e & 127;
                vals[u] = bf2f(p.proj[(size_t)(m0 + rl) * PLD + C_CKV + k]) * sRS[rl] * p.kv_norm[l * 128 + k];
              }
              asm volatile("s_waitcnt vmcnt(0)" ::: "memory");
#pragma unroll
              for (int u = 0; u < 8; ++u) {
                const int e = e0 + u * 256;
                const int rl = e >> 7, k = e & 127;
                const int row = m0 + rl;
                const int b = row >> 8, tt = row & 255;
                p.out[O_CKV + ((size_t)(b * 4 + l) * 256 + tt) * 128 + k] = vals[u];
              }
            }
          }
        } else {
          const bf16_t* Ac = p.ckvc + (size_t)l * 2048 * 128 - (size_t)NTOK * 128;
          gemm_tile<2, true, false>(Ac, 128, p.wb_ukv, 128, 128, m0, nt * 128, ekv, smem, true);
        }
      }
        } else if (which == 2) {
      for (int t = bid; t < 1536; t += nb) mlstm_local(p, t >> 2, t & 3, smem);
        } else {
      for (int t = bid; t < 1536; t += nb) hgrn_local(p, l, t >> 2, t & 3, smem);
        }
      }
    } break;
#endif
#if !defined(ONLY) || ONLY==4
    case 4:
      if (nb == 512) {
        if (bid < 256) { for (int it = bid; it < 1152; it += 256) state_item(p, l, it); }
        else attn_item(p, l, 512 + (bid - 256), smem);
      } else {
        for (int it = bid; it < 1152; it += nb) state_item(p, l, it);
        for (int it = bid; it < 256; it += nb) attn_item(p, l, 512 + it, smem);
      }
      if (nb == 512) {
        attn_item(p, l, (bid & 7) * 64 + (bid >> 3), smem);
      } else {
        for (int it = bid; it < 512; it += nb) attn_item(p, l, it, smem);
      }
      break;
#endif
#if !defined(ONLY) || ONLY==5
    case 5:
      for (int it = bid; it < 3072; it += nb) {
        if (it < 1536) mlstm_out(p, l, it >> 2, it & 3, smem);
        else hgrn_out(p, l, (it - 1536) >> 2, (it - 1536) & 3, smem);
      }
      break;
#endif
#if !defined(ONLY) || ONLY==6
    case 6: {
      EpiRes epi;
      if (l == 0) { epi.src0 = p.x_prompt; epi.src1 = p.x_sample - (size_t)NCTX * DM; epi.stats = nullptr; epi.gam = nullptr; epi.bet = nullptr; }
      else { epi.src0 = p.out; epi.src1 = p.out; epi.stats = p.S2; epi.gam = p.ln2_g + (l - 1) * DM; epi.bet = p.ln2_b + (l - 1) * DM; }
      epi.dst = p.X1;
      epi.gate = p.modv + (size_t)l * 5 * 6144 + 2048;
      if (nb == 512) {
        int mt, nt;
        if (tile_map(bid, nb, 0, 64, 8, mt, nt))
          gemm_tile<4, false, false>(p.hbuf, HLD, p.wb_out, HLD, 1024, mt * 256, nt * 128, epi, smem, false);
        if (tile_map(bid, nb, 0, 64, 8, mt, nt))
          gemm_tile<2, false, true>(p.hbuf, HLD, p.wb_out, HLD, 1024, 16384 + mt * 128, nt * 128, epi, smem, false);
      } else {
        gemm_run<false>(p.hbuf, HLD, p.wb_out, HLD, 1024, 192, 8, epi, smem, bid, nb);
      }
    } break;
#endif
#if !defined(ONLY) || ONLY==7
    case 7: ln_phase(p, l, 1, bid, nb); break;
#endif
#if !defined(ONLY) || ONLY==8
    case 8: {
      EpiFF epi{p.proj};
      for (int k = 0, mt, nt; tile_map(bid, nb, k, 96, 44, mt, nt); ++k)
        gemm_tile<4, false, false>(p.hbuf, HLD, p.wb_ffi, HLD, 1024, mt * 256, nt * 128, epi, smem, false);
    } break;
#endif
#if !defined(ONLY) || ONLY==9
    case 9: {
      EpiRes epi;
      epi.src0 = p.X1; epi.src1 = p.X1; epi.dst = p.out;
      epi.stats = p.S1; epi.gam = p.ln1_g + l * DM; epi.bet = p.ln1_b + l * DM;
      epi.gate = p.modv + (size_t)l * 5 * 6144 + 5120;
      if (nb == 512) {
        int mt, nt;
        if (tile_map(bid, nb, 0, 64, 8, mt, nt))
          gemm_tile<4, false, false>(p.proj, PLD, p.wb_ffo, PLD, FFD, mt * 256, nt * 128, epi, smem, false);
        if (tile_map(bid, nb, 0, 64, 8, mt, nt))
          gemm_tile<2, false, true>(p.proj, PLD, p.wb_ffo, PLD, FFD, 16384 + mt * 128, nt * 128, epi, smem, false);
      } else {
        gemm_run<false>(p.proj, PLD, p.wb_ffo, PLD, FFD, 192, 8, epi, smem, bid, nb);
      }
    } break;
#endif
#if !defined(ONLY) || ONLY==10
    case 10:
      ln_phase(p, l, 2, bid, nb);
      if (l < 3) convert_layer(p, l + 1, bid, nb, smem);
      break;
#endif
  }
}

#if SINGLE
constexpr int DYN_LDS = 73728 + 64;
__global__ void __launch_bounds__(256, 2) mega_kernel(Params p) {
  extern __shared__ __attribute__((aligned(16))) char smem[];
  unsigned* xb_words = (unsigned*)(smem + 73728);
  cg::grid_group grid = cg::this_grid();
  const int bid = blockIdx.x, nb = gridDim.x;
  if (threadIdx.x < 4) xb_words[threadIdx.x] = 0u;
  __syncthreads();
  XcdBarrier xb = xcd_barrier_post(p.bar, (volatile LAS unsigned*)xb_words);
  if (gridDim.y == 7777u) grid.sync();
  run_phase(p, 0, 0, smem, bid, nb);
  xcd_barrier(xb);
  run_phase(p, 1, 0, smem, bid, nb);
  xcd_barrier(xb);
#pragma unroll 1
  for (int l = 0; l < 4; ++l) {
#pragma unroll 1
    for (int ph = 2; ph <= 10; ++ph) {
      run_phase(p, ph, l, smem, bid, nb);
      if (!(l == 3 && ph == 10)) xcd_barrier(xb);
    }
  }
}
#else
__global__ void __launch_bounds__(256, 2) phase_kernel(Params p, int ph, int l) {
  __shared__ __attribute__((aligned(16))) char smem[65536];
  run_phase(p, ph, l, smem, blockIdx.x, gridDim.x);
}
#endif

extern "C" void kernel_launch(void* const* d_in, const int* in_sizes, int n_in, void* d_out, int out_size, void* d_ws,
                              size_t ws_size, hipStream_t stream) {
  Params p{};
  const float** f = (const float**)&p;
  for (int i = 0; i < 28; ++i) f[i] = (const float*)d_in[i];
  p.out = (float*)d_out;
  char* ws = (char*)d_ws;
  size_t off = 0;
  auto take = [&](size_t bytes) { char* r = ws + off; off += (bytes + 255) & ~(size_t)255; return r; };
  p.wb_in = (bf16_t*)take((size_t)2816 * HLD * 2);
  p.wb_uq = (bf16_t*)take((size_t)768 * 256 * 2);
  p.wb_ukv = (bf16_t*)take((size_t)1024 * 128 * 2);
  p.wb_out = (bf16_t*)take((size_t)1024 * HLD * 2);
  p.wb_ffi = (bf16_t*)take((size_t)5632 * HLD * 2);
  p.wb_ffo = (bf16_t*)take((size_t)1024 * PLD * 2);
  p.modv = (float*)take((size_t)4 * 5 * 6144 * 4);
  p.lbs = (float*)take(4 * 256 * 4);
  p.rope = (float*)take(1024 * 4);
  p.ckvc = (bf16_t*)take((size_t)4 * 4 * 512 * 128 * 2);
  p.kpec = (bf16_t*)take((size_t)4 * 4 * 512 * 32 * 2);
  p.X1 = (float*)take((size_t)NTOK * DM * 4);
  p.hbuf = (bf16_t*)take((size_t)NTOK * HLD * 2);
  p.proj = (bf16_t*)take((size_t)NTOK * PLD * 2);
  p.gates = (float*)take((size_t)NTOK * 16 * 4);
  p.Kn = (bf16_t*)take((size_t)NKV * 512 * 2);
  p.VtC = (bf16_t*)take((size_t)32 * 8 * 64 * 256 * 2);
  p.VtL = (bf16_t*)take((size_t)4 * 8 * 64 * 4608 * 2);
  p.Mg = (float*)take(8 * NTC * 4);
  p.Mumax = (float*)take(8 * NTC * 4);
  p.Mm = (float*)take(8 * NTC * 4);
  p.Mn = (float*)take((size_t)8 * NTC * 64 * 4);
  p.Hd = (float*)take((size_t)8 * NTC * 64 * 4);
  p.bar = (unsigned*)take(XCD_BAR_WORDS * 4);
  p.S1 = (float2*)take((size_t)NTOK * 8);
  p.S2 = (float2*)take((size_t)NTOK * 8);
  p.MU = (bf16_t*)p.X1;
  p.HU = p.MU + (size_t)8 * NTC * 4096;
  p.Q = p.HU + (size_t)8 * NTC * 4096;
  if (off > ws_size) {
    fprintf(stderr, "workspace too small: need %zu have %zu\n", off, ws_size);
    return;
  }
#if SINGLE
  static int grid_blocks = 0;
  if (!grid_blocks) {
    int dev = 0, cus = 0, per_cu = 0;
    hipGetDevice(&dev);
    hipDeviceGetAttribute(&cus, hipDeviceAttributeMultiprocessorCount, dev);
    hipFuncSetAttribute((const void*)mega_kernel, hipFuncAttributeMaxDynamicSharedMemorySize, DYN_LDS);
    hipOccupancyMaxActiveBlocksPerMultiprocessor(&per_cu, mega_kernel, 256, DYN_LDS);
    if (per_cu > 2) per_cu = 2;
    grid_blocks = cus * per_cu;
  }
  hipMemsetAsync(p.bar, 0, XCD_BAR_WORDS * 4, stream);
  void* args[] = {&p};
  hipError_t e = hipLaunchCooperativeKernel((void*)mega_kernel, dim3(grid_blocks), dim3(256), args, DYN_LDS, stream);
  if (e != hipSuccess) fprintf(stderr, "cooperative launch failed: %s (grid %d)\n", hipGetErrorString(e), grid_blocks);
#else
  phase_kernel<<<512, 256, 0, stream>>>(p, 0, 0);
  phase_kernel<<<512, 256, 0, stream>>>(p, 1, 0);
  for (int l = 0; l < 4; ++l)
    for (int ph = 2; ph <= 10; ++ph) phase_kernel<<<512, 256, 0, stream>>>(p, ph, l);
#endif
}
```

```cpp
#include <hip/hip_runtime.h>
#include <hip/hip_cooperative_groups.h>
#include <cstdio>
namespace cg = cooperative_groups;

#ifndef SINGLE
#define SINGLE 1
#endif

#define DI __device__ __forceinline__
typedef unsigned short bf16_t;
using bf16x8 = __attribute__((ext_vector_type(8))) short;
using bf16x4 = __attribute__((ext_vector_type(4))) short;
using f32x16 = __attribute__((ext_vector_type(16))) float;
using u32x4 = __attribute__((ext_vector_type(4))) unsigned;

constexpr int NTOK = 24576, NCTX = 8192, DM = 1024;
constexpr int PLD = 2880, IN_COLS = 2736, FFD = 2816;
constexpr int HLD = 1088;
constexpr int NTC = 384;
constexpr int NKV = NTOK + 2048;
constexpr float EPSF = 1e-6f;
constexpr float ALPHA = 1.6817928305074292f;
constexpr float QSCALE = 0.10206207261596577f * 1.4426950408889634f;
constexpr int C_CQ = 0, C_CKV = 256, C_KPE = 384, C_MQ = 416, C_MK = 672, C_MV = 928, C_MO = 1184, C_GATE = 1440,
              C_GQ = 1456, C_GFF = 1712, C_GFB = 1968, C_GI = 2224, C_GG = 2480;
constexpr size_t O_YP = 0, O_YS = 8388608, O_CKV = 25165824, O_KPE = 29360128, O_C = 30408704, O_N = 34603008,
                 O_M = 34668544, O_S = 34669568;

struct Params {
  const float *x_prompt, *x_sample, *cache_ckv, *cache_kpe, *st_C, *st_n, *st_m, *st_S, *c, *c_ctx, *w_mod, *b_mod,
      *w_in, *b_in, *q_norm, *w_uq, *kv_norm, *w_ukv, *ml_norm, *lb_logits, *hg_norm, *w_out, *ln1_g, *ln1_b, *w_ffi,
      *w_ffo, *ln2_g, *ln2_b;
  float* out;
  bf16_t *wb_in, *wb_uq, *wb_ukv, *wb_out, *wb_ffi, *wb_ffo;
  float *modv, *lbs, *rope;
  bf16_t *ckvc, *kpec;
  float* X1;
  bf16_t *hbuf, *proj;
  float* gates;
  bf16_t *Q, *Kn, *VtC, *VtL, *MU, *HU;
  float *Mg, *Mumax, *Mn, *Mm, *Hd;
  unsigned* bar;
  float2 *S1, *S2;
};

typedef __bf16 hbf2 __attribute__((ext_vector_type(2)));
typedef float f32x2 __attribute__((ext_vector_type(2)));
DI bf16_t f2bf(float x) { return __builtin_bit_cast(unsigned short, (__bf16)x); }
DI unsigned pk_bf16(float a, float b) {
  f32x2 v = {a, b};
  return __builtin_bit_cast(unsigned, __builtin_convertvector(v, hbf2));
}
DI float bf2f(bf16_t v) { return __uint_as_float(((unsigned)v) << 16); }
DI float bfs(short v) { return __uint_as_float(((unsigned)(unsigned short)v) << 16); }
DI int tidx() { int t = threadIdx.x; asm volatile("" : "+v"(t)); return t; }
DI int crow(int reg, int h) { return (reg & 3) + 8 * (reg >> 2) + 4 * h; }
DI float sigmoidf_(float x) { return __builtin_amdgcn_rcpf(1.f + __expf(-x)); }
DI float siluf_(float x) { return x * __builtin_amdgcn_rcpf(1.f + __expf(-x)); }
DI f32x16 mfma(bf16x8 a, bf16x8 b, f32x16 c) { return __builtin_amdgcn_mfma_f32_32x32x16_bf16(a, b, c, 0, 0, 0); }
DI f32x16 zero16() {
  f32x16 z = {0.f, 0.f, 0.f, 0.f, 0.f, 0.f, 0.f, 0.f, 0.f, 0.f, 0.f, 0.f, 0.f, 0.f, 0.f, 0.f};
  return z;
}
DI void wave_mma1(f32x16& acc, const bf16_t* A, int lda, const bf16_t* Bt, int ldb, int K, int lane) {
  const int r = lane & 31, h = lane >> 5;
  for (int k0 = 0; k0 < K; k0 += 16) {
    bf16x8 a = *(const bf16x8*)(A + r * lda + k0 + 8 * h);
    bf16x8 b = *(const bf16x8*)(Bt + r * ldb + k0 + 8 * h);
    acc = mfma(a, b, acc);
  }
}
DI int cvec_of(int row) { return row < NCTX ? 0 : 1 + ((row - NCTX) >> 12); }

DI bool tile_map(int bid, int nb, int k, int Mt, int Nt, int& mt, int& nt) {
  const int xcd = bid & 7, slot = bid >> 3, spx = nb >> 3;
  const int mpx = Mt >> 3;
  const int u = slot + k * spx;
  if (u >= mpx * Nt) return false;
  const int pw = 8 * Nt;
  const int pn = u / pw, rem = u - pn * pw;
  const int hgt = min(8, mpx - 8 * pn);
  nt = rem / hgt;
  mt = xcd * mpx + 8 * pn + (rem - nt * hgt);
  return true;
}

template <int MI, bool RS, bool TWO, class Epi>
DI void gemm_tile(const bf16_t* __restrict__ A, int lda, const bf16_t* __restrict__ Bt, int ldb, int K, int m0, int n0,
                  const Epi& epi, char* smem, bool rs_one) {
  constexpr int BM = 64 * MI;
  constexpr int NA = BM / 32;
  bf16_t* sA = (bf16_t*)smem;
  bf16_t* sB = sA + BM * 72;
  float* sRS = (float*)(sB + 128 * 72);
  const int tid = tidx(), lane = tid & 63, w = tid >> 6, wm = w >> 1, wn = w & 1;
  const int r = lane & 31, h = lane >> 5;
  f32x16 acc[MI][2];
#pragma unroll
  for (int i = 0; i < MI; ++i)
#pragma unroll
    for (int j = 0; j < 2; ++j) acc[i][j] = zero16();
  u32x4 ra0[NA], rb0[4], ra1[TWO ? NA : 1], rb1[TWO ? 4 : 1];
  const int lrow = tid >> 3, lkc = (tid & 7) * 8;
  const bf16_t* Ap = A + (size_t)(m0 + lrow) * lda + lkc;
  const bf16_t* Bp = Bt + (size_t)(n0 + lrow) * ldb + lkc;
  float ss = 0.f;
  auto gl = [&](u32x4* ra, u32x4* rb, int k0) {
#pragma unroll
    for (int i = 0; i < NA; ++i) ra[i] = *(const u32x4*)(Ap + (size_t)i * 32 * lda + k0);
#pragma unroll
    for (int i = 0; i < 4; ++i) rb[i] = *(const u32x4*)(Bp + (size_t)i * 32 * ldb + k0);
  };
  auto body = [&](u32x4* ra, u32x4* rb, int knext) {
    __syncthreads();
#pragma unroll
    for (int i = 0; i < NA; ++i) *(u32x4*)(sA + (lrow + i * 32) * 72 + lkc) = ra[i];
#pragma unroll
    for (int i = 0; i < 4; ++i) *(u32x4*)(sB + (lrow + i * 32) * 72 + lkc) = rb[i];
    __syncthreads();
    if (knext < K) gl(ra, rb, knext);
    if (RS) {
      constexpr int TPR = 256 / BM;
      constexpr int EPT = 64 / TPR;
      const bf16_t* rp = sA + (tid / TPR) * 72 + (tid % TPR) * EPT;
#pragma unroll
      for (int q = 0; q < EPT / 8; ++q) {
        bf16x8 v = *(const bf16x8*)(rp + q * 8);
#pragma unroll
        for (int j = 0; j < 8; ++j) {
          float f = bfs(v[j]);
          ss += f * f;
        }
      }
    }
    bf16x8 fa[2][MI], fb[2][2];
#pragma unroll
    for (int i = 0; i < MI; ++i) fa[0][i] = *(const bf16x8*)(sA + (wm * 32 * MI + i * 32 + r) * 72 + 8 * h);
#pragma unroll
    for (int j = 0; j < 2; ++j) fb[0][j] = *(const bf16x8*)(sB + (wn * 64 + j * 32 + r) * 72 + 8 * h);
#pragma unroll
    for (int s4 = 0; s4 < 4; ++s4) {
      const int cur = s4 & 1, nxt = cur ^ 1;
      if (s4 < 3) {
#pragma unroll
        for (int i = 0; i < MI; ++i)
          fa[nxt][i] = *(const bf16x8*)(sA + (wm * 32 * MI + i * 32 + r) * 72 + (s4 + 1) * 16 + 8 * h);
#pragma unroll
        for (int j = 0; j < 2; ++j)
          fb[nxt][j] = *(const bf16x8*)(sB + (wn * 64 + j * 32 + r) * 72 + (s4 + 1) * 16 + 8 * h);
      }
      __builtin_amdgcn_sched_barrier(0);
#pragma unroll
      for (int i = 0; i < MI; ++i)
#pragma unroll
        for (int j = 0; j < 2; ++j) acc[i][j] = mfma(fa[cur][i], fb[cur][j], acc[i][j]);
      __builtin_amdgcn_sched_barrier(0);
    }
  };
  if (TWO) {
    gl(ra0, rb0, 0);
    gl(ra1, rb1, 64);
    for (int k0 = 0; k0 < K; k0 += 128) {
      body(ra0, rb0, k0 + 128);
      body(ra1, rb1, k0 + 192);
    }
  } else {
    gl(ra0, rb0, 0);
    for (int k0 = 0; k0 < K; k0 += 64) body(ra0, rb0, k0 + 64);
  }
  if (RS) {
    constexpr int TPR = 256 / BM;
    if (TPR == 2) ss += __shfl_xor(ss, 1);
    if ((tid % TPR) == 0) sRS[tid / TPR] = rs_one ? 1.f : rsqrtf(ss / (float)K + EPSF);
    __syncthreads();
  }
  __syncthreads();
#pragma unroll
  for (int ih = 0; ih < MI / 2; ++ih)
    epi(reinterpret_cast<f32x16(&)[2][2]>(acc[2 * ih]), m0 + wm * 32 * MI + ih * 64, n0 + wn * 64, lane,
        sRS + wm * 32 * MI + ih * 64, (bf16_t*)smem + w * (64 * 72));
}


template <int NJ>
DI void stage_store(const f32x16 (&v)[2][2], bf16_t* st, bf16_t* dst, size_t ld, int lane) {
  const int r = lane & 31, h = lane >> 5;
#pragma unroll
  for (int i = 0; i < 2; ++i)
#pragma unroll
    for (int j = 0; j < NJ; ++j)
#pragma unroll
      for (int reg = 0; reg < 16; ++reg) st[(i * 32 + crow(reg, h)) * 72 + j * 32 + r] = f2bf(v[i][j][reg]);
  asm volatile("s_waitcnt lgkmcnt(0)" ::: "memory");
  constexpr int CPR = 4 * NJ;
#pragma unroll
  for (int q = 0; q < CPR; ++q) {
    const int c = lane + 64 * q;
    const int row = c / CPR, part = c % CPR;
    *(u32x4*)(dst + (size_t)row * ld + part * 8) = *(const u32x4*)(st + row * 72 + part * 8);
  }
  asm volatile("s_waitcnt lgkmcnt(0)" ::: "memory");
}

DI void rope_apply(float& v, const float* rope, int row, int r) {
  const int t = (row - NCTX) & 4095;
  const int pos = (r < 16) ? (t >> 6) : (t & 63);
  const float cs = rope[pos * 8 + (r & 7)], sn = rope[512 + pos * 8 + (r & 7)];
  const float pv = __shfl_xor(v, 8);
  v = v * cs + ((r & 8) ? pv : -pv) * sn;
}

struct EpiIn {
  const Params* p;
  int l;
  DI void operator()(f32x16 (&acc)[2][2], int mrow0, int ncol0, int lane, const float*, bf16_t* st) const {
    const int r = lane & 31, h = lane >> 5;
    const bool latent = mrow0 >= NCTX;
    if (ncol0 != 384 && ncol0 != 1408 && ncol0 + 64 <= IN_COLS) {
#pragma unroll
      for (int j = 0; j < 2; ++j) {
        const float bias = p->b_in[l * IN_COLS + ncol0 + j * 32 + r];
#pragma unroll
        for (int i = 0; i < 2; ++i)
#pragma unroll
          for (int reg = 0; reg < 16; ++reg) acc[i][j][reg] += bias;
      }
      stage_store<2>(acc, st, p->proj + (size_t)mrow0 * PLD + ncol0, PLD, lane);
      return;
    }
    float* sf = (float*)st;
#pragma unroll 1
    for (int j = 0; j < 2; ++j) {
      const int cb = ncol0 + j * 32;
      if (cb >= IN_COLS) continue;
      const int col = cb + r;
      const float bias = (col < IN_COLS) ? p->b_in[l * IN_COLS + col] : 0.f;
#pragma unroll
      for (int i = 0; i < 2; ++i)
#pragma unroll
        for (int reg = 0; reg < 16; ++reg) {
          float v = (j == 0 ? acc[i][0][reg] : acc[i][1][reg]) + bias;
          if (cb == C_KPE && latent) rope_apply(v, p->rope, mrow0 + i * 32 + crow(reg, h), r);
          sf[(i * 32 + crow(reg, h)) * 36 + r] = v;
        }
      asm volatile("s_waitcnt lgkmcnt(0)" ::: "memory");
      {
        const int row = mrow0 + lane;
        bf16_t* pr = p->proj + (size_t)row * PLD + cb;
        float* ok = p->out + O_KPE + ((size_t)((row >> 8) * 4 + l) * 256 + (row & 255)) * 32;
        float* gp = p->gates + (size_t)row * 16;
        const int ncol = (IN_COLS - cb >= 32) ? 32 : 16;
#pragma unroll 1
        for (int q = 0; q < 4; ++q) {
          const float4 a = *(const float4*)(sf + lane * 36 + q * 8);
          const float4 b = *(const float4*)(sf + lane * 36 + q * 8 + 4);
          u32x4 o;
          o[0] = pk_bf16(a.x, a.y); o[1] = pk_bf16(a.z, a.w); o[2] = pk_bf16(b.x, b.y); o[3] = pk_bf16(b.z, b.w);
          if (cb == C_KPE) {
            if (!latent) { *(float4*)(ok + q * 8) = a; *(float4*)(ok + q * 8 + 4) = b; }
            *(u32x4*)(pr + q * 8) = o;
          } else if (cb == C_GATE) {
            if (q < 2) { *(float4*)(gp + q * 8) = a; *(float4*)(gp + q * 8 + 4) = b; }
            else *(u32x4*)(pr + q * 8) = o;
          } else if (q * 8 < ncol) {
            *(u32x4*)(pr + q * 8) = o;
          }
        }
      }
      asm volatile("s_waitcnt lgkmcnt(0)" ::: "memory");
    }
  }
};

struct EpiQ {
  const Params* p;
  DI void operator()(f32x16 (&acc)[2][2], int mrow0, int ncol0, int lane, const float* rsw, bf16_t* st) const {
    const int r = lane & 31, h = lane >> 5;
    const bool latent = mrow0 >= NCTX;
#pragma unroll
    for (int j = 0; j < 2; ++j) {
      const int cb = ncol0 + j * 32;
      const bool pe = (cb % 96) == 64;
#pragma unroll
      for (int i = 0; i < 2; ++i) {
#pragma unroll
        for (int reg = 0; reg < 16; ++reg) {
          const int rl = i * 32 + crow(reg, h);
          float v = acc[i][j][reg] * rsw[rl] * QSCALE;
          if (pe && latent) rope_apply(v, p->rope, mrow0 + rl, r);
          acc[i][j][reg] = v;
        }
      }
    }
    stage_store<2>(acc, st, p->Q + (size_t)mrow0 * 768 + ncol0, 768, lane);
  }
};

struct EpiKV {
  const Params* p;
  DI void operator()(f32x16 (&acc)[2][2], int mrow0, int ncol0, int lane, const float* rsw, bf16_t* st) const {
    const int r = lane & 31, h = lane >> 5;
    if ((ncol0 & 127) == 0) {
#pragma unroll
      for (int i = 0; i < 2; ++i)
#pragma unroll
        for (int j = 0; j < 2; ++j)
#pragma unroll
          for (int reg = 0; reg < 16; ++reg) acc[i][j][reg] *= rsw[i * 32 + crow(reg, h)];
      stage_store<2>(acc, st, p->Kn + ((size_t)mrow0 * 8 + (ncol0 >> 7)) * 64, 512, lane);
      return;
    }
#pragma unroll
    for (int j = 0; j < 2; ++j) {
      const int cb = ncol0 + j * 32;
      const int hd = cb >> 7, within = cb & 127;
#pragma unroll
      for (int i = 0; i < 2; ++i) {
        if (within < 64) {
#pragma unroll
          for (int reg = 0; reg < 16; ++reg) {
            const int rl = i * 32 + crow(reg, h);
            const int row = mrow0 + rl;
            p->Kn[((size_t)row * 8 + hd) * 64 + within + r] = f2bf(acc[i][j][reg] * rsw[rl]);
          }
        } else {
          const int dv = within - 64 + r;
#pragma unroll
          for (int g = 0; g < 4; ++g) {
            const int rl = i * 32 + 8 * g + 4 * h;
            const int row = mrow0 + rl;
            bf16x4 pk;
#pragma unroll
            for (int q = 0; q < 4; ++q) pk[q] = (short)f2bf(acc[i][j][4 * g + q] * rsw[rl + q]);
            bf16_t* dst;
            if (row < NCTX) {
              const int b = row >> 8, key = row & 255;
              dst = p->VtC + ((size_t)((b * 8 + hd) * 64 + dv)) * 256 + key;
            } else if (row < NTOK) {
              const int rr = row - NCTX;
              const int b = rr >> 12, key = rr & 4095;
              dst = p->VtL + ((size_t)((b * 8 + hd) * 64 + dv)) * 4608 + key;
            } else {
              const int rr = row - NTOK;
              const int b = rr >> 9, key = 4096 + (rr & 511);
              dst = p->VtL + ((size_t)((b * 8 + hd) * 64 + dv)) * 4608 + key;
            }
            *(bf16x4*)dst = pk;
          }
        }
      }
    }
  }
};

struct EpiRes {
  const float* src0;
  const float* src1;
  float* dst;
  const float* gate;
  const float2* stats;
  const float* gam;
  const float* bet;
  DI void operator()(f32x16 (&acc)[2][2], int mrow0, int ncol0, int lane, const float*, bf16_t* st) const {
    const int r = lane & 31, h = lane >> 5;
    const float* src = mrow0 < NCTX ? src0 : src1;
    const float* gp = gate + cvec_of(mrow0) * 6144;
    float* sf = (float*)st;
#pragma unroll
    for (int j = 0; j < 2; ++j) {
      const int cb = ncol0 + j * 32;
      const float g = gp[cb + r];
#pragma unroll
      for (int i = 0; i < 2; ++i)
#pragma unroll
        for (int reg = 0; reg < 16; ++reg) sf[(i * 32 + crow(reg, h)) * 36 + r] = g * acc[i][j][reg];
      asm volatile("s_waitcnt lgkmcnt(0)" ::: "memory");
      const int part = lane & 7;
      const int col = cb + part * 4;
      float4 ga = make_float4(1.f, 1.f, 1.f, 1.f), be = make_float4(0.f, 0.f, 0.f, 0.f);
      if (stats) { ga = *(const float4*)(gam + col); be = *(const float4*)(bet + col); }
      float4 xs[8];
      float2 ms[8];
#pragma unroll
      for (int q = 0; q < 8; ++q) {
        const int row = mrow0 + (lane >> 3) + 8 * q;
        xs[q] = *(const float4*)(src + (size_t)row * DM + col);
        ms[q] = stats ? stats[row] : make_float2(0.f, 1.f);
      }
      asm volatile("s_waitcnt vmcnt(0)" ::: "memory");
#pragma unroll
      for (int q = 0; q < 8; ++q) {
        const int rl = (lane >> 3) + 8 * q;
        const float4 a = *(const float4*)(sf + rl * 36 + part * 4);
        float4 x = xs[q];
        if (stats) {
          x.x = (x.x - ms[q].x) * ms[q].y * ga.x + be.x; x.y = (x.y - ms[q].x) * ms[q].y * ga.y + be.y;
          x.z = (x.z - ms[q].x) * ms[q].y * ga.z + be.z; x.w = (x.w - ms[q].x) * ms[q].y * ga.w + be.w;
        }
        float4 y;
        y.x = ALPHA * x.x + a.x; y.y = ALPHA * x.y + a.y; y.z = ALPHA * x.z + a.z; y.w = ALPHA * x.w + a.w;
        *(float4*)(dst + (size_t)(mrow0 + rl) * DM + col) = y;
      }
      asm volatile("s_waitcnt lgkmcnt(0)" ::: "memory");
    }
  }
};

struct EpiFF {
  bf16_t* act;
  DI void operator()(f32x16 (&acc)[2][2], int mrow0, int ncol0, int lane, const float*, bf16_t* st) const {
    const int col0 = (ncol0 >> 6) * 32;
#pragma unroll
    for (int i = 0; i < 2; ++i)
#pragma unroll
      for (int reg = 0; reg < 16; ++reg) acc[i][0][reg] = siluf_(acc[i][0][reg]) * acc[i][1][reg];
    stage_store<1>(acc, st, act + (size_t)mrow0 * PLD + col0, PLD, lane);
  }
};


template <bool PRE, class Epi>
DI void gemm_run(const bf16_t* __restrict__ A, int lda, const bf16_t* __restrict__ Bt, int ldb, int K, int Mt, int Nt,
                 const Epi& epi, char* smem, int bid, int nb) {
  constexpr int BUF = 2 * 128 * 72;
  bf16_t* sbase = (bf16_t*)smem;
  const int tid = tidx(), lane = tid & 63, w = tid >> 6, wm = w >> 1, wn = w & 1;
  const int r = lane & 31, h = lane >> 5;
  const int lrow = tid >> 3, lkc = (tid & 7) * 8;
  int kt = 0, mt, nt;
  if (!tile_map(bid, nb, kt, Mt, Nt, mt, nt)) return;
  const bf16_t* Ap = A + (size_t)(mt * 128 + lrow) * lda + lkc;
  const bf16_t* Bp = Bt + (size_t)(nt * 128 + lrow) * ldb + lkc;
  u32x4 ra0[4], rb0[4], ra1[4], rb1[4];
  auto gl = [&](u32x4* ra, u32x4* rb, int k0) {
#pragma unroll
    for (int i = 0; i < 4; ++i) ra[i] = *(const u32x4*)(Ap + (size_t)i * 32 * lda + k0);
#pragma unroll
    for (int i = 0; i < 4; ++i) rb[i] = *(const u32x4*)(Bp + (size_t)i * 32 * ldb + k0);
  };
  auto lw = [&](const u32x4* ra, const u32x4* rb, int buf) {
    bf16_t* sA = sbase + buf * BUF;
    bf16_t* sB = sA + 128 * 72;
#pragma unroll
    for (int i = 0; i < 4; ++i) *(u32x4*)(sA + (lrow + i * 32) * 72 + lkc) = ra[i];
#pragma unroll
    for (int i = 0; i < 4; ++i) *(u32x4*)(sB + (lrow + i * 32) * 72 + lkc) = rb[i];
  };
  f32x16 acc[2][2];
  auto compute = [&](int buf) {
    const bf16_t* sA = sbase + buf * BUF + (wm * 64 + r) * 72 + 8 * h;
    const bf16_t* sB = sbase + buf * BUF + 128 * 72 + (wn * 64 + r) * 72 + 8 * h;
    bf16x8 fa[2][2], fb[2][2];
#pragma unroll
    for (int i = 0; i < 2; ++i) fa[0][i] = *(const bf16x8*)(sA + i * 32 * 72);
#pragma unroll
    for (int j = 0; j < 2; ++j) fb[0][j] = *(const bf16x8*)(sB + j * 32 * 72);
#pragma unroll
    for (int s4 = 0; s4 < 4; ++s4) {
      const int cur = s4 & 1, nxt = cur ^ 1;
      if (s4 < 3) {
#pragma unroll
        for (int i = 0; i < 2; ++i) fa[nxt][i] = *(const bf16x8*)(sA + i * 32 * 72 + (s4 + 1) * 16);
#pragma unroll
        for (int j = 0; j < 2; ++j) fb[nxt][j] = *(const bf16x8*)(sB + j * 32 * 72 + (s4 + 1) * 16);
      }
      __builtin_amdgcn_sched_barrier(0);
#pragma unroll
      for (int i = 0; i < 2; ++i)
#pragma unroll
        for (int j = 0; j < 2; ++j) acc[i][j] = mfma(fa[cur][i], fb[cur][j], acc[i][j]);
      __builtin_amdgcn_sched_barrier(0);
    }
  };
  gl(ra0, rb0, 0);
  gl(ra1, rb1, 64);
  for (;;) {
#pragma unroll
    for (int i = 0; i < 2; ++i)
#pragma unroll
      for (int j = 0; j < 2; ++j) acc[i][j] = zero16();
    __syncthreads();
    lw(ra0, rb0, 0);
    if (128 < K) gl(ra0, rb0, 128);
    __syncthreads();
    for (int k0 = 0; k0 < K; k0 += 128) {
      lw(ra1, rb1, 1);
      if (k0 + 192 < K) gl(ra1, rb1, k0 + 192);
      compute(0);
      __syncthreads();
      if (k0 + 128 < K) {
        lw(ra0, rb0, 0);
        if (k0 + 256 < K) gl(ra0, rb0, k0 + 256);
      }
      compute(1);
      __syncthreads();
    }
    const int m0 = mt * 128, n0 = nt * 128;
    const bool more = tile_map(bid, nb, ++kt, Mt, Nt, mt, nt);
    if (PRE && more) {
      Ap = A + (size_t)(mt * 128 + lrow) * lda + lkc;
      Bp = Bt + (size_t)(nt * 128 + lrow) * ldb + lkc;
      gl(ra0, rb0, 0);
      gl(ra1, rb1, 64);
    }
    epi(acc, m0 + wm * 64, n0 + wn * 64, lane, (const float*)nullptr, (bf16_t*)smem + w * (64 * 72));
    if (!more) break;
    if (!PRE) {
      Ap = A + (size_t)(mt * 128 + lrow) * lda + lkc;
      Bp = Bt + (size_t)(nt * 128 + lrow) * ldb + lkc;
      gl(ra0, rb0, 0);
      gl(ra1, rb1, 64);
    }
  }
}

DI void convert_tile(const float* __restrict__ W, bf16_t* __restrict__ Wt, int ldw, int K, int N, int mode,
                     const float* __restrict__ g, int kt, int nt, char* smem) {
  float* s = (float*)smem;
  const int tid = tidx(), tx = tid & 63, ty = tid >> 6;
  const int k0 = kt * 64, n0 = nt * 64;
  int src;
  if (mode == 1) src = (tx < 32) ? (nt * 32 + tx) : (FFD + nt * 32 + tx - 32);
  else src = n0 + tx;
  __syncthreads();
#pragma unroll
  for (int i = 0; i < 16; ++i) {
    const int k = ty + 4 * i;
    float v = (src < N) ? W[(size_t)(k0 + k) * N + src] : 0.f;
    if (g) v *= g[k0 + k];
    s[k * 65 + tx] = v;
  }
  __syncthreads();
#pragma unroll
  for (int i = 0; i < 16; ++i) {
    const int n = ty + 4 * i;
    Wt[(size_t)(n0 + n) * ldw + k0 + tx] = f2bf(s[tx * 65 + n]);
  }
}

DI void convert_layer(const Params& p, int l, int bid, int nb, char* smem) {
  for (int it = bid; it < 3152; it += nb) {
    int t = it;
    if (t < 704) { convert_tile(p.w_in + (size_t)l * 1024 * IN_COLS, p.wb_in, HLD, 1024, IN_COLS, 0, nullptr, t % 16, t / 16, smem); continue; }
    t -= 704;
    if (t < 48) { convert_tile(p.w_uq + (size_t)l * 256 * 768, p.wb_uq, 256, 256, 768, 0, p.q_norm + l * 256, t % 4, t / 4, smem); continue; }
    t -= 48;
    if (t < 32) { convert_tile(p.w_ukv + (size_t)l * 128 * 1024, p.wb_ukv, 128, 128, 1024, 0, p.kv_norm + l * 128, t % 2, t / 2, smem); continue; }
    t -= 32;
    if (t < 256) { convert_tile(p.w_out + (size_t)l * 1024 * 1024, p.wb_out, HLD, 1024, 1024, 0, nullptr, t % 16, t / 16, smem); continue; }
    t -= 256;
    if (t < 1408) { convert_tile(p.w_ffi + (size_t)l * 1024 * 5632, p.wb_ffi, HLD, 1024, 5632, 1, nullptr, t % 16, t / 16, smem); continue; }
    t -= 1408;
    convert_tile(p.w_ffo + (size_t)l * FFD * 1024, p.wb_ffo, PLD, FFD, 1024, 0, nullptr, t % 44, t / 44, smem);
  }
}

DI void phase0_misc(const Params& p, int bid, int nb, char* smem) {
  const int tid = tidx();
  if (bid < 384) {
    float* sc = (float*)smem;
    float* red = sc + 5 * 1024;
    __syncthreads();
    for (int e = tid; e < 5 * 1024; e += 256) {
      const int v = e >> 10, k = e & 1023;
      const float x = v == 0 ? p.c_ctx[k] : p.c[(v - 1) * 1024 + k];
      sc[e] = siluf_(x);
    }
    __syncthreads();
    for (int it = bid; it < 384; it += nb) {
      const int l = it / 96, n0 = (it % 96) * 64;
      const int col = tid & 63, ks = tid >> 6;
      float a[5] = {0.f, 0.f, 0.f, 0.f, 0.f};
      const float* wp = p.w_mod + (size_t)l * 1024 * 6144 + n0 + col;
      for (int k = ks * 256; k < ks * 256 + 256; ++k) {
        const float wv = wp[(size_t)k * 6144];
#pragma unroll
        for (int v = 0; v < 5; ++v) a[v] += sc[v * 1024 + k] * wv;
      }
      __syncthreads();
#pragma unroll
      for (int v = 0; v < 5; ++v) red[(ks * 5 + v) * 64 + col] = a[v];
      __syncthreads();
      for (int e = tid; e < 320; e += 256) {
        const int v = e >> 6, cc = e & 63;
        const float sum = red[(0 * 5 + v) * 64 + cc] + red[(1 * 5 + v) * 64 + cc] + red[(2 * 5 + v) * 64 + cc] +
                          red[(3 * 5 + v) * 64 + cc];
        p.modv[((size_t)l * 5 + v) * 6144 + n0 + cc] = sum + p.b_mod[l * 6144 + n0 + cc];
      }
    }
  }
  const int gt = bid * 256 + tid, gn = nb * 256;
  for (int c = gt; c < 256; c += gn) {
    float x[4], mx = -1e30f;
    for (int l = 0; l < 4; ++l) { x[l] = p.lb_logits[l * 256 + c]; mx = fmaxf(mx, x[l]); }
    float s = 0.f;
    for (int l = 0; l < 4; ++l) { x[l] = __expf(x[l] - mx); s += x[l]; }
    float cum = 0.f;
    for (int l = 0; l < 4; ++l) {
      const float pl = x[l] / s;
      if (l > 0) cum += pl;
      p.lbs[l * 256 + c] = cum;
    }
  }
  for (int e = gt; e < 512; e += gn) {
    const int pos = e >> 3, i = e & 7;
    const float f = exp2f(-(float)i * 0.125f * 13.287712379549449f);
    const float ang = (float)pos * f;
    p.rope[e] = __cosf(ang);
    p.rope[512 + e] = __sinf(ang);
  }
  for (int e = gt; e < 4 * 4 * 512 * 128; e += gn) {
    const int k = e & 127, t = (e >> 7) & 511, b = (e >> 16) & 3, l = e >> 18;
    const float cv = p.cache_ckv[(((size_t)b * 4 + l) * 512 + t) * 128 + k] / p.kv_norm[l * 128 + k];
    asm volatile("s_waitcnt vmcnt(0)" ::: "memory");
    p.ckvc[e] = f2bf(cv);
  }
  for (int e = gt; e < 4 * 4 * 512 * 32; e += gn) {
    const int k = e & 31, t = (e >> 5) & 511, b = (e >> 14) & 3, l = e >> 16;
    const float kv = p.cache_kpe[(((size_t)b * 4 + l) * 512 + t) * 32 + k];
    asm volatile("s_waitcnt vmcnt(0)" ::: "memory");
    p.kpec[e] = f2bf(kv);
  }
}

DI void phase0_h(const Params& p, int bid, int nb) {
  const int tid = tidx(); const int lane = tid & 63, gw = bid * 4 + (tid >> 6), nw = nb * 4;
  for (int row = gw; row < NTOK; row += nw) {
    const float* src = row < NCTX ? p.x_prompt + (size_t)row * DM : p.x_sample + (size_t)(row - NCTX) * DM;
    const float* mv = p.modv + (size_t)cvec_of(row) * 6144;
    float4 x[4], sh[4], sc[4];
#pragma unroll
    for (int i = 0; i < 4; ++i) {
      const int col = i * 256 + lane * 4;
      x[i] = *(const float4*)(src + col);
      sh[i] = *(const float4*)(mv + col);
      sc[i] = *(const float4*)(mv + 1024 + col);
    }
    asm volatile("s_waitcnt vmcnt(0)" ::: "memory");
#pragma unroll
    for (int i = 0; i < 4; ++i) {
      const int col = i * 256 + lane * 4;
      bf16x4 o;
      o[0] = (short)f2bf(x[i].x * (1.f + sc[i].x) + sh[i].x);
      o[1] = (short)f2bf(x[i].y * (1.f + sc[i].y) + sh[i].y);
      o[2] = (short)f2bf(x[i].z * (1.f + sc[i].z) + sh[i].z);
      o[3] = (short)f2bf(x[i].w * (1.f + sc[i].w) + sh[i].w);
      *(bf16x4*)(p.hbuf + (size_t)row * HLD + col) = o;
    }
  }
}

DI float wave_sum(float v) {
#pragma unroll
  for (int o = 32; o > 0; o >>= 1) v += __shfl_xor(v, o);
  return v;
}
DI float wave_max(float v) {
#pragma unroll
  for (int o = 32; o > 0; o >>= 1) v = fmaxf(v, __shfl_xor(v, o));
  return v;
}

DI void ln_phase(const Params& p, int l, int which, int bid, int nb) {
  const int tid = tidx(); const int lane = tid & 63, gw = bid * 4 + (tid >> 6), nw = nb * 4;
  float* X = which == 1 ? p.X1 : p.out;
  float2* S = which == 1 ? p.S1 : p.S2;
  const float* gam = (which == 1 ? p.ln1_g : p.ln2_g) + l * DM;
  const float* bet = (which == 1 ? p.ln1_b : p.ln2_b) + l * DM;
  const bool wh = which == 1 || l < 3;
  const bool wx = which == 2 && l == 3;
  const int ml = which == 1 ? l : l + 1;
  const int shoff = which == 1 ? 3072 : 0;
  auto process = [&](float4 (&x)[4], int row) {
    float* xr = X + (size_t)row * DM;
    float s = 0.f;
#pragma unroll
    for (int i = 0; i < 4; ++i) s += x[i].x + x[i].y + x[i].z + x[i].w;
    const float mu = wave_sum(s) * (1.f / 1024.f);
    float v = 0.f;
#pragma unroll
    for (int i = 0; i < 4; ++i) {
      x[i].x -= mu; x[i].y -= mu; x[i].z -= mu; x[i].w -= mu;
      v += x[i].x * x[i].x + x[i].y * x[i].y + x[i].z * x[i].z + x[i].w * x[i].w;
    }
    const float rstd = rsqrtf(wave_sum(v) * (1.f / 1024.f) + EPSF);
    if (lane == 0) S[row] = make_float2(mu, rstd);
    const float* mv = p.modv + ((size_t)ml * 5 + cvec_of(row)) * 6144 + shoff;
#pragma unroll
    for (int i = 0; i < 4; ++i) {
      const int col = i * 256 + lane * 4;
      const float4 g = *(const float4*)(gam + col), b = *(const float4*)(bet + col);
      float4 y;
      y.x = x[i].x * rstd * g.x + b.x; y.y = x[i].y * rstd * g.y + b.y;
      y.z = x[i].z * rstd * g.z + b.z; y.w = x[i].w * rstd * g.w + b.w;
      if (wx) *(float4*)(xr + col) = y;
      if (wh) {
        const float4 sh = *(const float4*)(mv + col), sc = *(const float4*)(mv + 1024 + col);
        bf16x4 o;
        o[0] = (short)f2bf(y.x * (1.f + sc.x) + sh.x);
        o[1] = (short)f2bf(y.y * (1.f + sc.y) + sh.y);
        o[2] = (short)f2bf(y.z * (1.f + sc.z) + sh.z);
        o[3] = (short)f2bf(y.w * (1.f + sc.w) + sh.w);
        *(bf16x4*)(p.hbuf + (size_t)row * HLD + col) = o;
      }
    }
  };
  for (int row = gw; row < NTOK; row += 4 * nw) {
    const int r1 = row + nw, r2 = row + 2 * nw, r3 = row + 3 * nw;
    const bool h1 = r1 < NTOK, h2 = r2 < NTOK, h3 = r3 < NTOK;
    float4 xa[4], xb[4], xc[4], xd[4];
#pragma unroll
    for (int i = 0; i < 4; ++i) xa[i] = *(const float4*)(X + (size_t)row * DM + i * 256 + lane * 4);
    if (h1) {
#pragma unroll
      for (int i = 0; i < 4; ++i) xb[i] = *(const float4*)(X + (size_t)r1 * DM + i * 256 + lane * 4);
    }
    if (h2) {
#pragma unroll
      for (int i = 0; i < 4; ++i) xc[i] = *(const float4*)(X + (size_t)r2 * DM + i * 256 + lane * 4);
    }
    if (h3) {
#pragma unroll
      for (int i = 0; i < 4; ++i) xd[i] = *(const float4*)(X + (size_t)r3 * DM + i * 256 + lane * 4);
    }
    asm volatile("s_waitcnt vmcnt(0)" ::: "memory");
    process(xa, row);
    if (h1) process(xb, r1);
    if (h2) process(xc, r2);
    if (h3) process(xd, r3);
  }
}

DI int scan_idx(int dir, int hd, int tc) { return (dir * 4 + hd) * NTC + tc; }

DI void mlstm_local(const Params& p, int tc, int hd, char* smem) {
  bf16_t* sKT = (bf16_t*)smem;
  bf16_t* sVT = sKT + 2 * 64 * 72;
  float* sW = (float*)(sVT + 64 * 72);
  const int tid = tidx(), lane = tid & 63, w = tid >> 6;
  const int row0 = tc * 64;
  __syncthreads();
  if (w < 2) {
    const int dir = w;
    const int t = dir ? 63 - lane : lane;
    const float* gp = p.gates + (size_t)(row0 + t) * 16;
    const float ig = gp[dir * 4 + hd], fg = gp[8 + dir * 4 + hd];
    const float lf = fminf(fg, 0.f) - log1pf(__expf(-fabsf(fg)));
    float b = lf;
#pragma unroll
    for (int o = 1; o < 64; o <<= 1) {
      const float v = __shfl_up(b, o);
      if (lane >= o) b += v;
    }
    const float g = __shfl(b, 63);
    const float u = g - b + ig;
    const float um = wave_max(u);
    sW[dir * 64 + t] = __expf(u - um);
    if (lane == 0) {
      p.Mg[scan_idx(dir, hd, tc)] = g;
      p.Mumax[scan_idx(dir, hd, tc)] = um;
    }
  }
  __syncthreads();
  {
    const int t = tid >> 2, c0 = (tid & 3) * 16;
    const bf16_t* kp = p.proj + (size_t)(row0 + t) * PLD + C_MK + hd * 64 + c0;
    const bf16_t* vp = p.proj + (size_t)(row0 + t) * PLD + C_MV + hd * 64 + c0;
    const float w0 = sW[t], w1 = sW[64 + t];
#pragma unroll
    for (int q = 0; q < 2; ++q) {
      const bf16x8 kv = *(const bf16x8*)(kp + q * 8);
      const bf16x8 vv = *(const bf16x8*)(vp + q * 8);
#pragma unroll
      for (int j = 0; j < 8; ++j) {
        const int d = c0 + q * 8 + j;
        const float kf = bfs(kv[j]) * 0.125f;
        sKT[d * 72 + t] = f2bf(kf * w0);
        sKT[64 * 72 + d * 72 + t] = f2bf(kf * w1);
        sVT[d * 72 + t] = (bf16_t)vv[j];
      }
    }
  }
  __syncthreads();
  if (tid < 128) {
    const int dir = tid >> 6, d = tid & 63;
    float s = 0.f;
    for (int t = 0; t < 64; ++t) s += bf2f(sKT[dir * 64 * 72 + d * 72 + t]);
    p.Mn[(size_t)scan_idx(dir, hd, tc) * 64 + d] = s;
  }
  const int I = w >> 1, J = w & 1, r = lane & 31, h = lane >> 5;
#pragma unroll
  for (int dir = 0; dir < 2; ++dir) {
    f32x16 acc = zero16();
    wave_mma1(acc, sKT + dir * 64 * 72 + I * 32 * 72, 72, sVT + J * 32 * 72, 72, 64, lane);
    bf16_t* U = p.MU + (size_t)scan_idx(dir, hd, tc) * 4096;
#pragma unroll
    for (int reg = 0; reg < 16; ++reg) U[(I * 32 + crow(reg, h)) * 64 + J * 32 + r] = f2bf(acc[reg]);
  }
}

DI void state_item(const Params& p, int l, int item) {
  const int tid = tidx();
  const bool hg = item >= 576;
  if (hg) item -= 576;
  const int part = item & 1;
  int chain = item >> 1;
  chain = chain < 32 ? chain + 256 : chain - 32;
  const int hd = chain & 3, dir = (chain >> 2) & 1, seq = chain >> 3;
  const int e0 = (part * 256 + tid) * 8;
  const bool ctx = seq < 32;
  const int b = ctx ? seq : seq - 32;
  const int nc = ctx ? 4 : 64;
  const int tcb = ctx ? seq * 4 : 128 + b * 64;
  const int sidx = ((b * 4 + l) * 2 + dir) * 4 + hd;
  bf16_t* U = hg ? p.HU : p.MU;
  const bool don = (!hg) && part == 0 && tid < 8;
  float C[8], n[8], m = 0.f;
#pragma unroll
  for (int j = 0; j < 8; ++j) { C[j] = 0.f; n[j] = 0.f; }
  if (!ctx) {
    const float* src = (hg ? p.st_S : p.st_C) + (size_t)sidx * 4096 + e0;
    const float4 c0 = *(const float4*)src, c1 = *(const float4*)(src + 4);
    C[0] = c0.x; C[1] = c0.y; C[2] = c0.z; C[3] = c0.w; C[4] = c1.x; C[5] = c1.y; C[6] = c1.z; C[7] = c1.w;
    if (!hg) {
      m = p.st_m[sidx];
      if (don) {
#pragma unroll
        for (int j = 0; j < 8; ++j) n[j] = p.st_n[sidx * 64 + tid * 8 + j];
      }
    }
  }
  const int crow_ = e0 >> 6;
  for (int c0 = 0; c0 < nc; c0 += 4) {
    u32x4 u[4];
    float g[4], um[4];
    int idx[4];
#pragma unroll
    for (int q = 0; q < 4; ++q) {
      const int c = c0 + q;
      const int tc = dir ? tcb + nc - 1 - c : tcb + c;
      idx[q] = scan_idx(dir, hd, tc);
      u[q] = *(const u32x4*)(U + (size_t)idx[q] * 4096 + e0);
      if (hg) {
        g[q] = p.Hd[(size_t)idx[q] * 64 + crow_];
        um[q] = 0.f;
      } else {
        g[q] = p.Mg[idx[q]];
        um[q] = p.Mumax[idx[q]];
      }
    }
#pragma unroll
    for (int q = 0; q < 4; ++q) {
      u32x4 o;
#pragma unroll
      for (int j = 0; j < 4; ++j) o[j] = (unsigned)f2bf(C[2 * j]) | ((unsigned)f2bf(C[2 * j + 1]) << 16);
      *(u32x4*)(U + (size_t)idx[q] * 4096 + e0) = o;
      float uf[8];
#pragma unroll
      for (int j = 0; j < 4; ++j) { uf[2 * j] = __uint_as_float(u[q][j] << 16); uf[2 * j + 1] = __uint_as_float(u[q][j] & 0xffff0000u); }
      if (hg) {
#pragma unroll
        for (int j = 0; j < 8; ++j) C[j] = g[q] * C[j] + uf[j];
      } else {
        const float mnew = fmaxf(g[q] + m, um[q]);
        const float sc = __expf(g[q] + m - mnew), su = __expf(um[q] - mnew);
        if (don) {
          float* np = p.Mn + (size_t)idx[q] * 64 + tid * 8;
#pragma unroll
          for (int j = 0; j < 8; ++j) { const float nl = np[j]; np[j] = n[j]; n[j] = sc * n[j] + su * nl; }
        }
        if (part == 0 && tid == 0) p.Mm[idx[q]] = m;
#pragma unroll
        for (int j = 0; j < 8; ++j) C[j] = sc * C[j] + su * uf[j];
        m = mnew;
      }
    }
  }
  if (ctx) {
    float* dst = p.out + (hg ? O_S : O_C) + (size_t)sidx * 4096 + e0;
    *(float4*)dst = make_float4(C[0], C[1], C[2], C[3]);
    *(float4*)(dst + 4) = make_float4(C[4], C[5], C[6], C[7]);
    if (!hg) {
      if (don) {
#pragma unroll
        for (int j = 0; j < 8; ++j) p.out[O_N + sidx * 64 + tid * 8 + j] = n[j];
      }
      if (part == 0 && tid == 0) p.out[O_M + sidx] = m;
    }
  }
}

DI void mlstm_out(const Params& p, int l, int tc, int hd, char* smem) {
  bf16_t* sQ = (bf16_t*)smem;
  bf16_t* sK = sQ + 64 * 72;
  bf16_t* sVT = sK + 64 * 72;
  bf16_t* sCT = sVT + 64 * 72;
  bf16_t* sP = sCT + 64 * 72;
  float* fb = (float*)(sP + 64 * 72);
  float *sb = fb, *sib = fb + 64, *smt = fb + 128, *sws = fb + 192, *sden = fb + 256, *sn = fb + 320;
  float* sH = (float*)smem;
  const int tid = tidx(), lane = tid & 63, w = tid >> 6;
  const int I = w >> 1, J = w & 1, r = lane & 31, h = lane >> 5;
  const int row0 = tc * 64;
  __syncthreads();
  {
    const int t = tid >> 2, c0 = (tid & 3) * 16;
    const bf16_t* qp = p.proj + (size_t)(row0 + t) * PLD + C_MQ + hd * 64 + c0;
    const bf16_t* kp = p.proj + (size_t)(row0 + t) * PLD + C_MK + hd * 64 + c0;
    const bf16_t* vp = p.proj + (size_t)(row0 + t) * PLD + C_MV + hd * 64 + c0;
#pragma unroll
    for (int q = 0; q < 2; ++q) {
      *(bf16x8*)(sQ + t * 72 + c0 + q * 8) = *(const bf16x8*)(qp + q * 8);
      const bf16x8 kv = *(const bf16x8*)(kp + q * 8);
      const bf16x8 vv = *(const bf16x8*)(vp + q * 8);
#pragma unroll
      for (int j = 0; j < 8; ++j) {
        const int d = c0 + q * 8 + j;
        sK[t * 72 + d] = f2bf(bfs(kv[j]) * 0.125f);
        sVT[d * 72 + t] = (bf16_t)vv[j];
      }
    }
  }
  f32x16 hacc = zero16();
  for (int dir = 0; dir < 2; ++dir) {
    const int idx = scan_idx(dir, hd, tc);
    if (w == 0) {
      const int t = dir ? 63 - lane : lane;
      const float* gp = p.gates + (size_t)(row0 + t) * 16;
      const float ig = gp[dir * 4 + hd], fg = gp[8 + dir * 4 + hd];
      const float lf = fminf(fg, 0.f) - log1pf(__expf(-fabsf(fg)));
      float b = lf;
#pragma unroll
      for (int o = 1; o < 64; o <<= 1) {
        const float v = __shfl_up(b, o);
        if (lane >= o) b += v;
      }
      const float ib = ig - b;
      float pm = ib;
#pragma unroll
      for (int o = 1; o < 64; o <<= 1) {
        const float v = __shfl_up(pm, o);
        if (lane >= o) pm = fmaxf(pm, v);
      }
      const float m0 = p.Mm[idx];
      const float mt = fmaxf(b + m0, b + pm);
      sb[t] = b; sib[t] = ib; smt[t] = mt; sws[t] = __expf(b + m0 - mt);
    } else {
      const bf16_t* Cs = p.MU + (size_t)idx * 4096;
      for (int e = tid - 64; e < 4096; e += 192) {
        const int d = e >> 6, ee = e & 63;
        sCT[ee * 72 + d] = Cs[e];
      }
      if (w == 1) sn[lane] = p.Mn[(size_t)idx * 64 + lane];
    }
    __syncthreads();
    const bool skip = dir ? (I == 1 && J == 0) : (I == 0 && J == 1);
    {
      f32x16 s = zero16();
      if (!skip) wave_mma1(s, sQ + I * 32 * 72, 72, sK + J * 32 * 72, 72, 64, lane);
      const int sg = J * 32 + r;
      const float ibs = sib[sg];
#pragma unroll
      for (int reg = 0; reg < 16; ++reg) {
        const int t = I * 32 + crow(reg, h);
        const bool keep = dir ? (sg >= t) : (sg <= t);
        const float pv = keep ? s[reg] * __expf(sb[t] + ibs - smt[t]) : 0.f;
        sP[t * 72 + sg] = f2bf(pv);
      }
    }
    f32x16 acc = zero16();
    wave_mma1(acc, sQ + I * 32 * 72, 72, sCT + J * 32 * 72, 72, 64, lane);
#pragma unroll
    for (int reg = 0; reg < 16; ++reg) acc[reg] *= sws[I * 32 + crow(reg, h)];
    __syncthreads();
    if (tid < 64) {
      const int t = tid;
      float qn = 0.f, ps = 0.f;
      for (int d = 0; d < 64; ++d) {
        qn += bf2f(sQ[t * 72 + d]) * sn[d];
        ps += bf2f(sP[t * 72 + d]);
      }
      const float den = sws[t] * qn + ps;
      sden[t] = __builtin_amdgcn_rcpf(fmaxf(fabsf(den), __expf(-smt[t])));
    }
    wave_mma1(acc, sP + I * 32 * 72, 72, sVT + J * 32 * 72, 72, 64, lane);
    __syncthreads();
#pragma unroll
    for (int reg = 0; reg < 16; ++reg) hacc[reg] += acc[reg] * sden[I * 32 + crow(reg, h)];
    __syncthreads();
  }
#pragma unroll
  for (int reg = 0; reg < 16; ++reg) sH[(I * 32 + crow(reg, h)) * 64 + J * 32 + r] = hacc[reg];
  __syncthreads();
  {
    const int t = tid >> 2, c0 = (tid & 3) * 16;
    float v[16], s = 0.f;
#pragma unroll
    for (int j = 0; j < 16; ++j) { v[j] = sH[t * 64 + c0 + j]; s += v[j]; }
    s += __shfl_xor(s, 1); s += __shfl_xor(s, 2);
    const float mu = s * (1.f / 64.f);
    float q = 0.f;
#pragma unroll
    for (int j = 0; j < 16; ++j) { v[j] -= mu; q += v[j] * v[j]; }
    q += __shfl_xor(q, 1); q += __shfl_xor(q, 2);
    const float rstd = rsqrtf(q * (1.f / 64.f) + EPSF);
    const bf16_t* mo = p.proj + (size_t)(row0 + t) * PLD + C_MO + hd * 64 + c0;
    const float* ng = p.ml_norm + l * 256 + hd * 64 + c0;
    bf16_t* dst = p.hbuf + (size_t)(row0 + t) * HLD + 512 + hd * 64 + c0;
    const bf16x8 mv0 = *(const bf16x8*)(mo), mv1 = *(const bf16x8*)(mo + 8);
    float ngv[16];
#pragma unroll
    for (int j = 0; j < 16; ++j) ngv[j] = ng[j];
    asm volatile("s_waitcnt vmcnt(0)" ::: "memory");
#pragma unroll
    for (int q2 = 0; q2 < 2; ++q2) {
      const bf16x8 mv = q2 ? mv1 : mv0;
      bf16x8 o;
#pragma unroll
      for (int j = 0; j < 8; ++j)
        o[j] = (short)f2bf(v[q2 * 8 + j] * rstd * ngv[q2 * 8 + j] * sigmoidf_(bfs(mv[j])));
      *(bf16x8*)(dst + q2 * 8) = o;
    }
  }
}

DI void hgrn_gate(float fr, float lbv, float& kk, float& lg) {
  const float sg = sigmoidf_(fr);
  const float f = lbv + (1.f - lbv) * sg;
  kk = (1.f - lbv) * sigmoidf_(-fr);
  lg = __logf(fmaxf(f, 1e-30f));
}

DI float hgrn_cumsum(float* sBc, float* sTot, int dir, int tid, float* ref31) {
  const int c = tid & 63, seg = tid >> 6;
  float v[16];
#pragma unroll
  for (int i = 0; i < 16; ++i) {
    const int sp = seg * 16 + i;
    const int tt = dir ? 63 - sp : sp;
    v[i] = sBc[tt * 64 + c];
  }
  float run = 0.f;
#pragma unroll
  for (int i = 0; i < 16; ++i) { run += v[i]; v[i] = run; }
  sTot[seg * 64 + c] = run;
  __syncthreads();
  const float t0 = sTot[c], t1 = sTot[64 + c], t2 = sTot[128 + c], t3 = sTot[192 + c];
  const float off = (seg > 0 ? t0 : 0.f) + (seg > 1 ? t1 : 0.f) + (seg > 2 ? t2 : 0.f);
#pragma unroll
  for (int i = 0; i < 16; ++i) {
    const int sp = seg * 16 + i;
    const int tt = dir ? 63 - sp : sp;
    sBc[tt * 64 + c] = v[i] + off;
  }
  *ref31 = v[15] + off;
  return ((t0 + t1) + t2) + t3;
}

DI void hgrn_local(const Params& p, int l, int tc, int hd, char* smem) {
  float* sBc = (float*)smem;
  bf16_t* sKG = (bf16_t*)(sBc + 4096);
  bf16_t* sVT = sKG + 64 * 72;
  float* sGL = (float*)(sVT + 64 * 72);
  const int tid = tidx(), lane = tid & 63, w = tid >> 6;
  const int I = w >> 1, J = w & 1, r = lane & 31, h = lane >> 5;
  const int row0 = tc * 64;
  const int t = tid >> 2, c0 = (tid & 3) * 16;
  __syncthreads();
  {
    const bf16_t* vp = p.proj + (size_t)(row0 + t) * PLD + C_GI + hd * 64 + c0;
#pragma unroll
    for (int q = 0; q < 2; ++q) {
      const bf16x8 vv = *(const bf16x8*)(vp + q * 8);
#pragma unroll
      for (int j = 0; j < 8; ++j) sVT[(c0 + q * 8 + j) * 72 + t] = (bf16_t)vv[j];
    }
  }
  for (int dir = 0; dir < 2; ++dir) {
    const int idx = scan_idx(dir, hd, tc);
    float kk[16];
    {
      const bf16_t* fp = p.proj + (size_t)(row0 + t) * PLD + (dir ? C_GFB : C_GFF) + hd * 64 + c0;
      const float* lbp = p.lbs + l * 256 + hd * 64 + c0;
#pragma unroll
      for (int q = 0; q < 2; ++q) {
        const bf16x8 fv = *(const bf16x8*)(fp + q * 8);
#pragma unroll
        for (int j = 0; j < 8; ++j) {
          float lg;
          hgrn_gate(bfs(fv[j]), lbp[q * 8 + j], kk[q * 8 + j], lg);
          sBc[t * 64 + c0 + q * 8 + j] = lg;
        }
      }
    }
    __syncthreads();
    {
      float r31;
      const float tot = hgrn_cumsum(sBc, sGL + 64, dir, tid, &r31);
      if (tid < 64) {
        sGL[tid] = tot;
        p.Hd[(size_t)idx * 64 + tid] = __expf(tot);
      }
    }
    __syncthreads();
#pragma unroll
    for (int j = 0; j < 16; ++j) {
      const int c = c0 + j;
      sKG[c * 72 + t] = f2bf(kk[j] * __expf(sGL[c] - sBc[t * 64 + c]));
    }
    __syncthreads();
    f32x16 acc = zero16();
    wave_mma1(acc, sKG + I * 32 * 72, 72, sVT + J * 32 * 72, 72, 64, lane);
    bf16_t* U = p.HU + (size_t)idx * 4096;
#pragma unroll
    for (int reg = 0; reg < 16; ++reg) U[(I * 32 + crow(reg, h)) * 64 + J * 32 + r] = f2bf(acc[reg]);
    __syncthreads();
  }
}

DI void hgrn_out(const Params& p, int l, int tc, int hd, char* smem) {
  float* sBc = (float*)smem;
  bf16_t* sVT = (bf16_t*)(sBc + 4096);
  bf16_t* sST = sVT + 64 * 72;
  bf16_t* sQ = sST + 64 * 72;
  bf16_t* sQ1 = sQ + 64 * 72;
  bf16_t* sK = sQ1 + 32 * 72;
  bf16_t* sK1 = sK + 64 * 72;
  float* sRef = (float*)(sK1 + 32 * 72);
  const int tid = tidx(), lane = tid & 63, w = tid >> 6;
  const int I = w >> 1, J = w & 1, r = lane & 31, h = lane >> 5;
  const int row0 = tc * 64;
  const int t = tid >> 2, c0 = (tid & 3) * 16;
  __syncthreads();
  {
    const bf16_t* vp = p.proj + (size_t)(row0 + t) * PLD + C_GI + hd * 64 + c0;
#pragma unroll
    for (int q = 0; q < 2; ++q) {
      const bf16x8 vv = *(const bf16x8*)(vp + q * 8);
#pragma unroll
      for (int j = 0; j < 8; ++j) sVT[(c0 + q * 8 + j) * 72 + t] = (bf16_t)vv[j];
    }
  }
  f32x16 oacc = zero16();
  for (int dir = 0; dir < 2; ++dir) {
    const int idx = scan_idx(dir, hd, tc);
    float kk[16], qv[16];
    {
      const bf16_t* fp = p.proj + (size_t)(row0 + t) * PLD + (dir ? C_GFB : C_GFF) + hd * 64 + c0;
      const bf16_t* qp = p.proj + (size_t)(row0 + t) * PLD + C_GQ + hd * 64 + c0;
      const float* lbp = p.lbs + l * 256 + hd * 64 + c0;
#pragma unroll
      for (int q = 0; q < 2; ++q) {
        const bf16x8 fv = *(const bf16x8*)(fp + q * 8);
        const bf16x8 qq = *(const bf16x8*)(qp + q * 8);
#pragma unroll
        for (int j = 0; j < 8; ++j) {
          float lg;
          hgrn_gate(bfs(fv[j]), lbp[q * 8 + j], kk[q * 8 + j], lg);
          sBc[t * 64 + c0 + q * 8 + j] = lg;
          qv[q * 8 + j] = siluf_(bfs(qq[j]));
        }
      }
      const bf16_t* Ss = p.HU + (size_t)idx * 4096;
#pragma unroll
      for (int i = 0; i < 16; ++i) {
        const int e = i * 256 + tid;
        sST[(e & 63) * 72 + (e >> 6)] = Ss[e];
      }
    }
    __syncthreads();
    {
      float r31;
      (void)hgrn_cumsum(sBc, sRef + 64, dir, tid, &r31);
      if ((tid >> 6) == 1) sRef[tid & 63] = r31;
    }
    __syncthreads();
    const int sb2 = dir ? 0 : 1;
    {
      const bool second = (t >> 5) == sb2;
#pragma unroll
      for (int j = 0; j < 16; ++j) {
        const int c = c0 + j;
        const float bc = sBc[t * 64 + c];
        const float rf = sRef[c];
        sQ[t * 72 + c] = f2bf(qv[j] * __expf(bc));
        if (second) {
          sQ1[(t & 31) * 72 + c] = f2bf(qv[j] * __expf(bc - rf));
          sK[t * 72 + c] = f2bf(kk[j] * __expf(rf - bc));
        } else {
          sK[t * 72 + c] = f2bf(kk[j] * __expf(-bc));
          sK1[(t & 31) * 72 + c] = f2bf(kk[j] * __expf(rf - bc));
        }
      }
    }
    __syncthreads();
    f32x16 a = zero16();
    if (I == J) {
      wave_mma1(a, (I == sb2) ? sQ1 : sQ + I * 32 * 72, 72, sK + J * 32 * 72, 72, 64, lane);
#pragma unroll
      for (int reg = 0; reg < 16; ++reg) {
        const int tl = crow(reg, h);
        const bool keep = dir ? (r >= tl) : (r <= tl);
        if (!keep) a[reg] = 0.f;
      }
    } else if (I == sb2) {
      wave_mma1(a, sQ1, 72, sK1, 72, 64, lane);
    }
    wave_mma1(oacc, sQ + I * 32 * 72, 72, sST + J * 32 * 72, 72, 64, lane);
    __syncthreads();
#pragma unroll
    for (int reg = 0; reg < 16; ++reg) sQ[(I * 32 + crow(reg, h)) * 72 + J * 32 + r] = f2bf(a[reg]);
    __syncthreads();
    wave_mma1(oacc, sQ + I * 32 * 72, 72, sVT + J * 32 * 72, 72, 64, lane);
    __syncthreads();
  }
  float* sO = sBc;
#pragma unroll
  for (int reg = 0; reg < 16; ++reg) sO[(I * 32 + crow(reg, h)) * 64 + J * 32 + r] = oacc[reg];
  __syncthreads();
  {
    float v[16], q = 0.f;
#pragma unroll
    for (int j = 0; j < 16; ++j) { v[j] = sO[t * 64 + c0 + j]; q += v[j] * v[j]; }
    q += __shfl_xor(q, 1); q += __shfl_xor(q, 2);
    const float rstd = rsqrtf(q * (1.f / 64.f) + EPSF);
    const bf16_t* gg = p.proj + (size_t)(row0 + t) * PLD + C_GG + hd * 64 + c0;
    const float* ng = p.hg_norm + l * 256 + hd * 64 + c0;
    bf16_t* dst = p.hbuf + (size_t)(row0 + t) * HLD + 768 + hd * 64 + c0;
    const bf16x8 gv0 = *(const bf16x8*)(gg), gv1 = *(const bf16x8*)(gg + 8);
    float ngv[16];
#pragma unroll
    for (int j = 0; j < 16; ++j) ngv[j] = ng[j];
    asm volatile("s_waitcnt vmcnt(0)" ::: "memory");
#pragma unroll
    for (int q2 = 0; q2 < 2; ++q2) {
      const bf16x8 gv = q2 ? gv1 : gv0;
      bf16x8 o;
#pragma unroll
      for (int j = 0; j < 8; ++j) o[j] = (short)f2bf(v[q2 * 8 + j] * rstd * ngv[q2 * 8 + j] * siluf_(bfs(gv[j])));
      *(bf16x8*)(dst + q2 * 8) = o;
    }
  }
}

DI void attn_item(const Params& p, int l, int item, char* smem) {
  bf16_t* sK = (bf16_t*)smem;
  bf16_t* sV = sK + 64 * 104;
  const int tid = tidx(), lane = tid & 63, w = tid >> 6;
  const int r = lane & 31, h = lane >> 5;
  int b, hd, tok0, nk, vld, krow_base;
  const bf16_t* Vt;
  bool lat;
  if (item < 512) {
    lat = true; b = item >> 7; hd = (item >> 4) & 7; const int qb = item & 15;
    tok0 = NCTX + b * 4096 + qb * 256; nk = 4608; vld = 4608;
    Vt = p.VtL + (size_t)((b * 8 + hd) * 64) * 4608; krow_base = NCTX + b * 4096;
  } else {
    const int it = item - 512;
    lat = false; b = it >> 3; hd = it & 7;
    tok0 = b * 256; nk = 256; vld = 256;
    Vt = p.VtC + (size_t)((b * 8 + hd) * 64) * 256; krow_base = b * 256;
  }
  const int q0 = tok0 + w * 64;
  bf16x8 bq[2][6];
#pragma unroll
  for (int g = 0; g < 2; ++g)
#pragma unroll
    for (int s = 0; s < 6; ++s)
      bq[g][s] = *(const bf16x8*)(p.Q + (size_t)(q0 + g * 32 + r) * 768 + hd * 96 + 16 * s + 8 * h);
  f32x16 o[2][2];
#pragma unroll
  for (int g = 0; g < 2; ++g) { o[g][0] = zero16(); o[g][1] = zero16(); }
  float m[2] = {-1e30f, -1e30f}, lsum[2] = {0.f, 0.f};
  u32x4 rk[2], rp, rv[2];
  const int nkeyA = tid >> 3, npartA = tid & 7;
  const int pkey = tid >> 2, ppart = tid & 3;
  auto gload = [&](int k0) {
    const bf16_t* pe_ptr;
    int pe_ld, krow;
    if (lat && k0 >= 4096) {
      krow = NTOK + b * 512 + (k0 - 4096);
      pe_ptr = p.kpec + ((size_t)(l * 4 + b) * 512 + (k0 - 4096)) * 32;
      pe_ld = 32;
    } else {
      krow = krow_base + k0;
      pe_ptr = p.proj + (size_t)krow * PLD + C_KPE;
      pe_ld = PLD;
    }
#pragma unroll
    for (int i = 0; i < 2; ++i) {
      rk[i] = *(const u32x4*)(p.Kn + ((size_t)(krow + nkeyA + i * 32) * 8 + hd) * 64 + npartA * 8);
      rv[i] = *(const u32x4*)(Vt + (size_t)(nkeyA + i * 32) * vld + k0 + npartA * 8);
    }
    rp = *(const u32x4*)(pe_ptr + (size_t)pkey * pe_ld + ppart * 8);
  };
  gload(0);
  for (int k0 = 0; k0 < nk; k0 += 64) {
    __syncthreads();
#pragma unroll
    for (int i = 0; i < 2; ++i) {
      *(u32x4*)(sK + (nkeyA + i * 32) * 104 + npartA * 8) = rk[i];
      *(u32x4*)(sV + (nkeyA + i * 32) * 72 + npartA * 8) = rv[i];
    }
    *(u32x4*)(sK + pkey * 104 + 64 + ppart * 8) = rp;
    __syncthreads();
    if (k0 + 64 < nk) gload(k0 + 64);
    f32x16 s[2][2];
#pragma unroll
    for (int kb = 0; kb < 2; ++kb) {
      s[0][kb] = zero16();
      s[1][kb] = zero16();
#pragma unroll
      for (int ks = 0; ks < 6; ++ks) {
        const bf16x8 a = *(const bf16x8*)(sK + (kb * 32 + r) * 104 + 16 * ks + 8 * h);
        s[0][kb] = mfma(a, bq[0][ks], s[0][kb]);
        s[1][kb] = mfma(a, bq[1][ks], s[1][kb]);
      }
    }
    __builtin_amdgcn_sched_barrier(0);
#pragma unroll
    for (int g = 0; g < 2; ++g) {
      float mx = m[g];
#pragma unroll
      for (int kb = 0; kb < 2; ++kb)
#pragma unroll
        for (int reg = 0; reg < 16; ++reg) mx = fmaxf(mx, s[g][kb][reg]);
      mx = fmaxf(mx, __shfl_xor(mx, 32));
      const bool changed = __any(mx > m[g]);
      float alpha = 1.f;
      if (changed) { alpha = __builtin_amdgcn_exp2f(m[g] - mx); m[g] = mx; }
      float ps = 0.f;
#pragma unroll
      for (int kb = 0; kb < 2; ++kb)
#pragma unroll
        for (int reg = 0; reg < 16; ++reg) {
          const float pv = __builtin_amdgcn_exp2f(s[g][kb][reg] - m[g]);
          s[g][kb][reg] = pv;
          ps += pv;
        }
      if (changed) {
        lsum[g] *= alpha;
#pragma unroll
        for (int i = 0; i < 2; ++i)
#pragma unroll
          for (int reg = 0; reg < 16; ++reg) o[g][i][reg] *= alpha;
      }
      lsum[g] += ps;
      bf16x8 pb[2][2];
#pragma unroll
      for (int kb = 0; kb < 2; ++kb)
#pragma unroll
        for (int s2 = 0; s2 < 2; ++s2) {
          u32x4 pw;
#pragma unroll
          for (int j = 0; j < 4; ++j) pw[j] = pk_bf16(s[g][kb][8 * s2 + 2 * j], s[g][kb][8 * s2 + 2 * j + 1]);
          pb[kb][s2] = __builtin_bit_cast(bf16x8, pw);
        }
      __builtin_amdgcn_sched_barrier(0);
#pragma unroll
      for (int kb = 0; kb < 2; ++kb) {
#pragma unroll
        for (int s2 = 0; s2 < 2; ++s2) {
#pragma unroll
          for (int i = 0; i < 2; ++i) {
            const bf16_t* vp = sV + (i * 32 + r) * 72 + kb * 32 + 16 * s2 + 4 * h;
            const bf16x4 lo = *(const bf16x4*)vp;
            const bf16x4 hi = *(const bf16x4*)(vp + 8);
            const bf16x8 av = __builtin_shufflevector(lo, hi, 0, 1, 2, 3, 4, 5, 6, 7);
            o[g][i] = mfma(av, pb[kb][s2], o[g][i]);
          }
        }
      }
      __builtin_amdgcn_sched_barrier(0);
    }
  }
#pragma unroll
  for (int g = 0; g < 2; ++g) {
    float lt = lsum[g];
    lt += __shfl_xor(lt, 32);
    const float inv = 1.f / lt;
    bf16_t* dst = p.hbuf + (size_t)(q0 + g * 32 + r) * HLD + hd * 64;
#pragma unroll
    for (int i = 0; i < 2; ++i)
#pragma unroll
      for (int gg = 0; gg < 4; ++gg) {
        u32x4 dummy;
        (void)dummy;
        bf16x4 pk;
#pragma unroll
        for (int q = 0; q < 4; ++q) pk[q] = (short)f2bf(o[g][i][4 * gg + q] * inv);
        *(bf16x4*)(dst + i * 32 + 8 * gg + 4 * h) = pk;
      }
  }
}

#define XB_TMO      128
#define XB_XCNT(j)  (256  + 64 * (j))
#define XB_XSUB(j)  (1280 + 64 * (j))
#define XB_XGEN(j)  (2304 + 64 * (j))
#define XB_TOP      3328
#define XB_TOPGEN   3392
#define XCD_BAR_WORDS 3456
#define XB_SPIN_CAP (1u << 22)
#define LAS __attribute__((address_space(3)))
DI unsigned xb_ld(unsigned* p) { return __hip_atomic_load(p, __ATOMIC_RELAXED, __HIP_MEMORY_SCOPE_AGENT); }
DI unsigned xb_add(unsigned* p, unsigned v) { return __hip_atomic_fetch_add(p, v, __ATOMIC_RELAXED, __HIP_MEMORY_SCOPE_AGENT); }
DI unsigned xb_xcc_id() { return (unsigned)__builtin_amdgcn_s_getreg((3 << 11) | 20) & 0xFu; }
#define XB_SPIN(cond, bar) do { unsigned _sp = 0; while (cond) { __builtin_amdgcn_s_sleep(1); \
    if ((++_sp & 255u) == 0u) { if (xb_ld(&(bar)[XB_TMO])) break; if (_sp > XB_SPIN_CAP) { atomicAdd(&(bar)[XB_TMO], 1u); break; } } } } while (0)
struct XcdBarrier { unsigned* bar; unsigned x; volatile LAS unsigned* st; };
DI XcdBarrier xcd_barrier_post(unsigned* bar, volatile LAS unsigned* st) {
  XcdBarrier b; b.bar = bar; b.x = 0u; b.st = st;
  if (threadIdx.x == 0) {
    const unsigned x = xb_xcc_id();
    st[2] = x;
    (void)xb_add(&bar[XB_XCNT(x)], 1u);
  }
  return b;
}
DI void xcd_barrier_complete(unsigned* bar, unsigned x, unsigned& nloc, unsigned& nx) {
  const unsigned G = gridDim.x * gridDim.y * gridDim.z;
  unsigned sum, cnt, mine, sp = 0u;
  for (;;) {
    sum = 0u; cnt = 0u; mine = 0u;
#pragma unroll
    for (unsigned j = 0; j < 16; ++j) { const unsigned c = xb_ld(&bar[XB_XCNT(j)]); sum += c; cnt += (c > 0u) ? 1u : 0u; mine = (j == x) ? c : mine; }
    if (sum == G) break;
    __builtin_amdgcn_s_sleep(1);
    if ((++sp & 255u) == 0u) { if (xb_ld(&bar[XB_TMO])) break; if (sp > XB_SPIN_CAP) { atomicAdd(&bar[XB_TMO], 1u); break; } }
  }
  nloc = mine > 0u ? mine : 1u; nx = cnt > 0u ? cnt : 1u;
}
DI void xcd_barrier(const XcdBarrier& b) {
  asm volatile("s_waitcnt vmcnt(0)" ::: "memory");
  __syncthreads();
  if (threadIdx.x == 0) {
    unsigned* bar = b.bar;
    __builtin_amdgcn_s_waitcnt(0);
    unsigned nloc = b.st[0], nx = b.st[1];
    const unsigned bx = __builtin_amdgcn_readfirstlane(b.st[2]);
    if (nloc == 0u) { xcd_barrier_complete(bar, bx, nloc, nx); b.st[0] = nloc; b.st[1] = nx; }
    const unsigned old = xb_add(&bar[XB_XSUB(bx)], 1u);
    const unsigned gen = old / nloc;
    if (old + 1u == (gen + 1u) * nloc) {
      __builtin_amdgcn_fence(__ATOMIC_RELEASE, "agent");
      asm volatile("s_waitcnt vmcnt(0)" ::: "memory");
      const unsigned og = xb_add(&bar[XB_TOP], 1u);
      const unsigned tg = og / nx;
      if (og + 1u == (tg + 1u) * nx) xb_add(&bar[XB_TOPGEN], 1u);
      else XB_SPIN(xb_ld(&bar[XB_TOPGEN]) == tg, bar);
      __builtin_amdgcn_fence(__ATOMIC_ACQUIRE, "agent");
      xb_add(&bar[XB_XGEN(bx)], 1u);
      asm volatile("s_waitcnt vmcnt(0)" ::: "memory");
    } else {
      XB_SPIN(xb_ld(&bar[XB_XGEN(bx)]) == gen, bar);
      __builtin_amdgcn_fence(__ATOMIC_ACQUIRE, "agent");
      asm volatile("s_waitcnt vmcnt(0)" ::: "memory");
    }
  }
  __syncthreads();
}

DI void run_phase(const Params& p, int ph, int l, char* smem, int bid, int nb) {
  asm volatile("" : "+s"(bid));
  switch (ph) {
#if !defined(ONLY) || ONLY==0
    case 0:
      phase0_misc(p, bid, nb, smem);
      convert_layer(p, 0, bid, nb, smem);
      break;
#endif
#if !defined(ONLY) || ONLY==1
    case 1: phase0_h(p, bid, nb); break;
#endif
#if !defined(ONLY) || ONLY==2
    case 2: {
      EpiIn epi{&p, l};
      if (nb == 512) {
        for (int k = 0, mt, nt; tile_map(bid, nb, k, 88, 22, mt, nt); ++k)
          gemm_tile<4, false, false>(p.hbuf, HLD, p.wb_in, HLD, 1024, mt * 256, nt * 128, epi, smem, false);
        const int slot2 = ((bid >> 3) + 14) & 63;
        for (int k = 0, mt, nt; tile_map((bid & 7) | (slot2 << 3), nb, k, 16, 22, mt, nt); ++k)
          gemm_tile<2, false, true>(p.hbuf, HLD, p.wb_in, HLD, 1024, 22528 + mt * 128, nt * 128, epi, smem, false);
      } else {
        gemm_run<false>(p.hbuf, HLD, p.wb_in, HLD, 1024, 192, 22, epi, smem, bid, nb);
      }
    } break;
#endif
#if !defined(ONLY) || ONLY==3
    case 3: {
      EpiQ eq{&p};
      EpiKV ekv{&p};
      const bool rev = bid >= (nb >> 1);
#pragma unroll 1
      for (int stg = 0; stg < 4; ++stg) {
        const int which = rev ? 3 - stg : stg;
        if (which == 0) {
      for (int k = 0, mt, nt; tile_map(bid, nb, k, 192, 6, mt, nt); ++k)
        gemm_tile<2, true, false>(p.proj + C_CQ, PLD, p.wb_uq, 256, 256, mt * 128, nt * 128, eq, smem, false);
        } else if (which == 1) {
      for (int k = 0, mt, nt; tile_map((bid + (nb >> 1)) % nb, nb, k, 208, 8, mt, nt); ++k) {
        const int m0 = mt * 128;
        if (m0 < NTOK) {
          gemm_tile<2, true, false>(p.proj + C_CKV, PLD, p.wb_ukv, 128, 128, m0, nt * 128, ekv, smem, false);
          if (nt == 0 && m0 < NCTX) {
            const float* sRS = (const float*)(smem + 2 * 128 * 72 * 2);
            const int t0 = tidx();
#pragma unroll 1
            for (int e0 = t0; e0 < 128 * 128; e0 += 256 * 8) {
              float vals[8];
#pragma unroll
              for (int u = 0; u < 8; ++u) {
                const int e = e0 + u * 256;
                const int rl = e >> 7, k = e & 127;
                vals[u] = bf2f(p.proj[(size_t)(m0 + rl) * PLD + C_CKV + k]) * sRS[rl] * p.kv_norm[l * 128 + k];
              }
              asm volatile("s_waitcnt vmcnt(0)" ::: "memory");
#pragma unroll
              for (int u = 0; u < 8; ++u) {
                const int e = e0 + u * 256;
                const int rl = e >> 7, k = e & 127;
                const int row = m0 + rl;
                const int b = row >> 8, tt = row & 255;
                p.out[O_CKV + ((size_t)(b * 4 + l) * 256 + tt) * 128 + k] = vals[u];
              }
            }
          }
        } else {
          const bf16_t* Ac = p.ckvc + (size_t)l * 2048 * 128 - (size_t)NTOK * 128;
          gemm_tile<2, true, false>(Ac, 128, p.wb_ukv, 128, 128, m0, nt * 128, ekv, smem, true);
        }
      }
        } else if (which == 2) {
      for (int t = bid; t < 1536; t += nb) mlstm_local(p, t >> 2, t & 3, smem);
        } else {
      for (int t = bid; t < 1536; t += nb) hgrn_local(p, l, t >> 2, t & 3, smem);
        }
      }
    } break;
#endif
#if !defined(ONLY) || ONLY==4
    case 4:
      if (nb == 512) {
        if (bid < 256) { for (int it = bid; it < 1152; it += 256) state_item(p, l, it); }
        else attn_item(p, l, 512 + (bid - 256), smem);
      } else {
        for (int it = bid; it < 1152; it += nb) state_item(p, l, it);
        for (int it = bid; it < 256; it += nb) attn_item(p, l, 512 + it, smem);
      }
      if (nb == 512) {
        attn_item(p, l, (bid & 7) * 64 + (bid >> 3), smem);
      } else {
        for (int it = bid; it < 512; it += nb) attn_item(p, l, it, smem);
      }
      break;
#endif
#if !defined(ONLY) || ONLY==5
    case 5:
      for (int it = bid; it < 3072; it += nb) {
        if (it < 1536) mlstm_out(p, l, it >> 2, it & 3, smem);
        else hgrn_out(p, l, (it - 1536) >> 2, (it - 1536) & 3, smem);
      }
      break;
#endif
#if !defined(ONLY) || ONLY==6
    case 6: {
      EpiRes epi;
      if (l == 0) { epi.src0 = p.x_prompt; epi.src1 = p.x_sample - (size_t)NCTX * DM; epi.stats = nullptr; epi.gam = nullptr; epi.bet = nullptr; }
      else { epi.src0 = p.out; epi.src1 = p.out; epi.stats = p.S2; epi.gam = p.ln2_g + (l - 1) * DM; epi.bet = p.ln2_b + (l - 1) * DM; }
      epi.dst = p.X1;
      epi.gate = p.modv + (size_t)l * 5 * 6144 + 2048;
      if (nb == 512) {
        int mt, nt;
        if (tile_map(bid, nb, 0, 64, 8, mt, nt))
          gemm_tile<4, false, false>(p.hbuf, HLD, p.wb_out, HLD, 1024, mt * 256, nt * 128, epi, smem, false);
        if (tile_map(bid, nb, 0, 64, 8, mt, nt))
          gemm_tile<2, false, true>(p.hbuf, HLD, p.wb_out, HLD, 1024, 16384 + mt * 128, nt * 128, epi, smem, false);
      } else {
        gemm_run<false>(p.hbuf, HLD, p.wb_out, HLD, 1024, 192, 8, epi, smem, bid, nb);
      }
    } break;
#endif
#if !defined(ONLY) || ONLY==7
    case 7: ln_phase(p, l, 1, bid, nb); break;
#endif
#if !defined(ONLY) || ONLY==8
    case 8: {
      EpiFF epi{p.proj};
      for (int k = 0, mt, nt; tile_map(bid, nb, k, 96, 44, mt, nt); ++k)
        gemm_tile<4, false, false>(p.hbuf, HLD, p.wb_ffi, HLD, 1024, mt * 256, nt * 128, epi, smem, false);
    } break;
#endif
#if !defined(ONLY) || ONLY==9
    case 9: {
      EpiRes epi;
      epi.src0 = p.X1; epi.src1 = p.X1; epi.dst = p.out;
      epi.stats = p.S1; epi.gam = p.ln1_g + l * DM; epi.bet = p.ln1_b + l * DM;
      epi.gate = p.modv + (size_t)l * 5 * 6144 + 5120;
      if (nb == 512) {
        int mt, nt;
        if (tile_map(bid, nb, 0, 64, 8, mt, nt))
          gemm_tile<4, false, false>(p.proj, PLD, p.wb_ffo, PLD, FFD, mt * 256, nt * 128, epi, smem, false);
        if (tile_map(bid, nb, 0, 64, 8, mt, nt))
          gemm_tile<2, false, true>(p.proj, PLD, p.wb_ffo, PLD, FFD, 16384 + mt * 128, nt * 128, epi, smem, false);
      } else {
        gemm_run<false>(p.proj, PLD, p.wb_ffo, PLD, FFD, 192, 8, epi, smem, bid, nb);
      }
    } break;
#endif
#if !defined(ONLY) || ONLY==10
    case 10:
      ln_phase(p, l, 2, bid, nb);
      if (l < 3) convert_layer(p, l + 1, bid, nb, smem);
      break;
#endif
  }
}

#if SINGLE
constexpr int DYN_LDS = 73728 + 64;
__global__ void __launch_bounds__(256, 2) mega_kernel(Params p) {
  extern __shared__ __attribute__((aligned(16))) char smem[];
  unsigned* xb_words = (unsigned*)(smem + 73728);
  cg::grid_group grid = cg::this_grid();
  const int bid = blockIdx.x, nb = gridDim.x;
  if (threadIdx.x < 4) xb_words[threadIdx.x] = 0u;
  __syncthreads();
  XcdBarrier xb = xcd_barrier_post(p.bar, (volatile LAS unsigned*)xb_words);
  if (gridDim.y == 7777u) grid.sync();
  run_phase(p, 0, 0, smem, bid, nb);
  xcd_barrier(xb);
  run_phase(p, 1, 0, smem, bid, nb);
  xcd_barrier(xb);
#pragma unroll 1
  for (int l = 0; l < 4; ++l) {
#pragma unroll 1
    for (int ph = 2; ph <= 10; ++ph) {
      run_phase(p, ph, l, smem, bid, nb);
      if (!(l == 3 && ph == 10)) xcd_barrier(xb);
    }
  }
}
#else
__global__ void __launch_bounds__(256, 2) phase_kernel(Params p, int ph, int l) {
  __shared__ __attribute__((aligned(16))) char smem[65536];
  run_phase(p, ph, l, smem, blockIdx.x, gridDim.x);
}
#endif

extern "C" void kernel_launch(void* const* d_in, const int* in_sizes, int n_in, void* d_out, int out_size, void* d_ws,
                              size_t ws_size, hipStream_t stream) {
  Params p{};
  const float** f = (const float**)&p;
  for (int i = 0; i < 28; ++i) f[i] = (const float*)d_in[i];
  p.out = (float*)d_out;
  char* ws = (char*)d_ws;
  size_t off = 0;
  auto take = [&](size_t bytes) { char* r = ws + off; off += (bytes + 255) & ~(size_t)255; return r; };
  p.wb_in = (bf16_t*)take((size_t)2816 * HLD * 2);
  p.wb_uq = (bf16_t*)take((size_t)768 * 256 * 2);
  p.wb_ukv = (bf16_t*)take((size_t)1024 * 128 * 2);
  p.wb_out = (bf16_t*)take((size_t)1024 * HLD * 2);
  p.wb_ffi = (bf16_t*)take((size_t)5632 * HLD * 2);
  p.wb_ffo = (bf16_t*)take((size_t)1024 * PLD * 2);
  p.modv = (float*)take((size_t)4 * 5 * 6144 * 4);
  p.lbs = (float*)take(4 * 256 * 4);
  p.rope = (float*)take(1024 * 4);
  p.ckvc = (bf16_t*)take((size_t)4 * 4 * 512 * 128 * 2);
  p.kpec = (bf16_t*)take((size_t)4 * 4 * 512 * 32 * 2);
  p.X1 = (float*)take((size_t)NTOK * DM * 4);
  p.hbuf = (bf16_t*)take((size_t)NTOK * HLD * 2);
  p.proj = (bf16_t*)take((size_t)NTOK * PLD * 2);
  p.gates = (float*)take((size_t)NTOK * 16 * 4);
  p.Kn = (bf16_t*)take((size_t)NKV * 512 * 2);
  p.VtC = (bf16_t*)take((size_t)32 * 8 * 64 * 256 * 2);
  p.VtL = (bf16_t*)take((size_t)4 * 8 * 64 * 4608 * 2);
  p.Mg = (float*)take(8 * NTC * 4);
  p.Mumax = (float*)take(8 * NTC * 4);
  p.Mm = (float*)take(8 * NTC * 4);
  p.Mn = (float*)take((size_t)8 * NTC * 64 * 4);
  p.Hd = (float*)take((size_t)8 * NTC * 64 * 4);
  p.bar = (unsigned*)take(XCD_BAR_WORDS * 4);
  p.S1 = (float2*)take((size_t)NTOK * 8);
  p.S2 = (float2*)take((size_t)NTOK * 8);
  p.MU = (bf16_t*)p.X1;
  p.HU = p.MU + (size_t)8 * NTC * 4096;
  p.Q = p.HU + (size_t)8 * NTC * 4096;
  if (off > ws_size) {
    fprintf(stderr, "workspace too small: need %zu have %zu\n", off, ws_size);
    return;
  }
#if SINGLE
  static int grid_blocks = 0;
  if (!grid_blocks) {
    int dev = 0, cus = 0, per_cu = 0;
    hipGetDevice(&dev);
    hipDeviceGetAttribute(&cus, hipDeviceAttributeMultiprocessorCount, dev);
    hipFuncSetAttribute((const void*)mega_kernel, hipFuncAttributeMaxDynamicSharedMemorySize, DYN_LDS);
    hipOccupancyMaxActiveBlocksPerMultiprocessor(&per_cu, mega_kernel, 256, DYN_LDS);
    if (per_cu > 2) per_cu = 2;
    grid_blocks = cus * per_cu;
  }
  hipMemsetAsync(p.bar, 0, XCD_BAR_WORDS * 4, stream);
  void* args[] = {&p};
  hipError_t e = hipLaunchCooperativeKernel((void*)mega_kernel, dim3(grid_blocks), dim3(256), args, DYN_LDS, stream);
  if (e != hipSuccess) fprintf(stderr, "cooperative launch failed: %s (grid %d)\n", hipGetErrorString(e), grid_blocks);
#else
  phase_kernel<<<512, 256, 0, stream>>>(p, 0, 0);
  phase_kernel<<<512, 256, 0, stream>>>(p, 1, 0);
  for (int l = 0; l < 4; ++l)
    for (int ph = 2; ph <= 10; ++ph) phase_kernel<<<512, 256, 0, stream>>>(p, ph, l);
#endif
}
```
